# Optimizing an MI355X kernel written in HIP

```python
import jax, jax.numpy as jnp
from jax import lax
import numpy as np

D_MODEL = 1024
BATCH = 16
SEQ = 2048
DEPTH = 2

SB_HEAD_DIM = 64
SB_HEADS = D_MODEL // (2 * SB_HEAD_DIM)
SB_WIDTH = SB_HEADS * SB_HEAD_DIM
MLA_NOPE_DIM = 64
MLA_ROPE_DIM = 32
MLA_V_DIM = 64
MLA_HEADS = D_MODEL // (2 * MLA_V_DIM)
MLA_Q_RANK = 256
MLA_KV_RANK = 128
MLA_WIDTH = MLA_HEADS * MLA_V_DIM
MIX_WIDTH = SB_WIDTH + MLA_WIDTH
IN_WIDTH = 3 * SB_WIDTH + MLA_Q_RANK + MLA_KV_RANK + MLA_ROPE_DIM
IN_SPLITS = (SB_WIDTH, 2 * SB_WIDTH, 3 * SB_WIDTH,
             3 * SB_WIDTH + MLA_Q_RANK, 3 * SB_WIDTH + MLA_Q_RANK + MLA_KV_RANK)
ROPE_BASE = 10000.0
Q_BLOCK = 128
N_EXPERTS = 32
N_GROUPS = 8
EXPERTS_PER_GROUP = N_EXPERTS // N_GROUPS
TOP_K = 2
D_EXPERT = 256
DISPATCH_BLOCK = 256
DEEPNORM_ALPHA = (2 * DEPTH) ** 0.25
DEEPNORM_BETA = (8 * DEPTH) ** -0.25
LN_EPS = 1e-5
RMS_EPS = 1e-6

kernel_name = "hybrid_stickbreak_mla_groupmoe_deepnorm_adaln"


def standardize(x):
    xf = x.astype(jnp.float32)
    mu = jnp.mean(xf, axis=-1, keepdims=True)
    var = jnp.mean(jnp.square(xf - mu), axis=-1, keepdims=True)
    return (xf - mu) * lax.rsqrt(var + LN_EPS)


def layer_norm(x, gain, bias):
    return (standardize(x) * gain.astype(jnp.float32) + bias.astype(jnp.float32)).astype(x.dtype)


def modulate(x, shift, scale):
    return (standardize(x) * (1.0 + scale.astype(jnp.float32)) + shift.astype(jnp.float32)).astype(x.dtype)


def rms_norm(x, gain):
    xf = x.astype(jnp.float32)
    y = xf * lax.rsqrt(jnp.mean(jnp.square(xf), axis=-1, keepdims=True) + RMS_EPS)
    return (y * gain.astype(jnp.float32)).astype(x.dtype)


def rope_tables(positions):
    inv_freq = ROPE_BASE ** (-jnp.arange(0, MLA_ROPE_DIM, 2, dtype=jnp.float32) / MLA_ROPE_DIM)
    ang = positions.astype(jnp.float32)[..., None] * inv_freq
    return jnp.cos(ang), jnp.sin(ang)


def apply_rope(t, cos, sin):
    t1, t2 = jnp.split(t.astype(jnp.float32), 2, axis=-1)
    return jnp.concatenate([t1 * cos - t2 * sin, t1 * sin + t2 * cos], axis=-1).astype(t.dtype)


def split_heads(t, n_heads):
    b, s, _ = t.shape
    return t.reshape(b, s, n_heads, -1).transpose(0, 2, 1, 3)


def merge_heads(t):
    b, h, s, d = t.shape
    return t.transpose(0, 2, 1, 3).reshape(b, s, h * d)


def stick_breaking_attention(q, k, v):
    scale = SB_HEAD_DIM ** -0.5
    outs = []
    for blk in range(q.shape[2] // Q_BLOCK):
        q0 = blk * Q_BLOCK
        end = q0 + Q_BLOCK
        z = jnp.einsum('bhqd,bhkd->bhqk', q[:, :, q0:end].astype(jnp.float32),
                       k[:, :, :end].astype(jnp.float32)) * scale
        strict = jnp.arange(end)[None, :] < (q0 + jnp.arange(Q_BLOCK))[:, None]
        log_keep = jnp.where(strict, jax.nn.log_sigmoid(-z), 0.0)
        later = lax.cumsum(log_keep, axis=3, reverse=True) - log_keep
        w = jnp.where(strict, jnp.exp(jax.nn.log_sigmoid(z) + later), 0.0)
        outs.append(jnp.einsum('bhqk,bhkd->bhqd', w.astype(v.dtype), v[:, :, :end]))
    return jnp.concatenate(outs, axis=2)


def mla_attention(q_nope, q_rope, k_nope, k_rope, v):
    scale = (MLA_NOPE_DIM + MLA_ROPE_DIM) ** -0.5
    outs = []
    for blk in range(q_nope.shape[2] // Q_BLOCK):
        q0 = blk * Q_BLOCK
        end = q0 + Q_BLOCK
        s = (jnp.einsum('bhqd,bhkd->bhqk', q_nope[:, :, q0:end].astype(jnp.float32),
                        k_nope[:, :, :end].astype(jnp.float32))
             + jnp.einsum('bhqr,bkr->bhqk', q_rope[:, :, q0:end].astype(jnp.float32),
                          k_rope[:, :end].astype(jnp.float32))) * scale
        causal = jnp.arange(end)[None, :] <= (q0 + jnp.arange(Q_BLOCK))[:, None]
        p = jax.nn.softmax(jnp.where(causal, s, -jnp.inf), axis=-1)
        outs.append(jnp.einsum('bhqk,bhkd->bhqd', p.astype(v.dtype), v[:, :, :end]))
    return jnp.concatenate(outs, axis=2)


def token_mixer(h, cos, sin, w_in, q_norm, kv_norm, w_uq, w_ukv, w_o):
    proj = h @ w_in
    sb_q, sb_k, sb_v, q_lat, kv_lat, k_rope = jnp.split(proj, IN_SPLITS, axis=-1)
    sb_out = stick_breaking_attention(split_heads(sb_q, SB_HEADS), split_heads(sb_k, SB_HEADS),
                                      split_heads(sb_v, SB_HEADS))
    q = split_heads(rms_norm(q_lat, q_norm) @ w_uq, MLA_HEADS)
    kv = split_heads(rms_norm(kv_lat, kv_norm) @ w_ukv, MLA_HEADS)
    q_rope = apply_rope(q[..., MLA_NOPE_DIM:], cos[:, None], sin[:, None])
    k_rope = apply_rope(k_rope, cos, sin)
    mla_out = mla_attention(q[..., :MLA_NOPE_DIM], q_rope, kv[..., :MLA_NOPE_DIM], k_rope,
                            kv[..., MLA_NOPE_DIM:])
    merged = jnp.concatenate([merge_heads(sb_out), merge_heads(mla_out)], axis=-1)
    return merged @ w_o


def moe_ffn(h, router_w, router_bias, w_gate, w_up, w_down):
    b, s, d = h.shape
    x = h.reshape(-1, d)
    n_tok = x.shape[0]
    scores = jax.nn.sigmoid(x.astype(jnp.float32) @ router_w.astype(jnp.float32))
    biased = (scores + router_bias.astype(jnp.float32)).reshape(n_tok, N_GROUPS, EXPERTS_PER_GROUP)
    group_score = lax.top_k(biased, TOP_K)[0].sum(-1)
    g_sel = jnp.argmax(group_score, axis=-1)
    in_group = jnp.take_along_axis(biased, g_sel[:, None, None], axis=1)[:, 0]
    _, local = lax.top_k(in_group, TOP_K)
    expert_idx = g_sel[:, None] * EXPERTS_PER_GROUP + local
    gate = jnp.take_along_axis(scores, expert_idx, axis=-1)
    gate = gate / jnp.sum(gate, axis=-1, keepdims=True)
    m = n_tok * TOP_K
    flat_e = expert_idx.reshape(m)
    flat_tok = jnp.repeat(jnp.arange(n_tok, dtype=jnp.int32), TOP_K)
    flat_gate = gate.reshape(m)
    order = jnp.argsort(flat_e)
    se, stok, sgate = flat_e[order], flat_tok[order], flat_gate[order]
    counts = jnp.bincount(flat_e, length=N_EXPERTS)
    padded = (counts + DISPATCH_BLOCK - 1) // DISPATCH_BLOCK * DISPATCH_BLOCK
    start = jnp.cumsum(counts) - counts
    pend = jnp.cumsum(padded)
    pstart = pend - padded
    dest = pstart[se] + jnp.arange(m, dtype=jnp.int32) - start[se]
    n_blocks = -(-m // DISPATCH_BLOCK) + N_EXPERTS
    buf = jnp.zeros((n_blocks * DISPATCH_BLOCK, d), x.dtype).at[dest].set(x[stok])
    block_e = jnp.minimum(jnp.searchsorted(pend, jnp.arange(n_blocks) * DISPATCH_BLOCK, side='right'),
                          N_EXPERTS - 1)

    def expert_block(args):
        xb, e = args
        return (jax.nn.silu(xb @ w_gate[e]) * (xb @ w_up[e])) @ w_down[e]

    y_buf = lax.map(expert_block, (buf.reshape(n_blocks, DISPATCH_BLOCK, d), block_e))
    y_buf = y_buf.reshape(n_blocks * DISPATCH_BLOCK, d)
    y = jax.ops.segment_sum(y_buf[dest] * sgate[:, None].astype(x.dtype), stok, num_segments=n_tok)
    return y.reshape(b, s, d)


def setup_inputs(seed: int = 0) -> dict:
    key = jax.random.key(seed)
    ks = jax.random.split(key, 20)
    f32 = jnp.float32

    def nrm(k, shape, scale):
        return jax.random.normal(k, shape, f32) * scale

    d_in = D_MODEL ** -0.5
    x = nrm(ks[0], (BATCH, SEQ, D_MODEL), 1.0)
    c = nrm(ks[1], (BATCH, D_MODEL), 1.0)
    offset = jax.random.randint(ks[2], (BATCH, 1), 0, 1024, dtype=jnp.int32)
    positions = offset + jnp.arange(SEQ, dtype=jnp.int32)[None, :]
    ada_w = nrm(ks[3], (DEPTH, D_MODEL, 6 * D_MODEL), 0.1 * d_in)
    ada_b = nrm(ks[4], (DEPTH, 6 * D_MODEL), 0.01)
    in_scale = jnp.concatenate([
        jnp.full((2 * SB_WIDTH,), d_in, f32),
        jnp.full((SB_WIDTH,), d_in * DEEPNORM_BETA, f32),
        jnp.full((MLA_Q_RANK + MLA_KV_RANK + MLA_ROPE_DIM,), d_in, f32)])
    w_in = nrm(ks[5], (DEPTH, D_MODEL, IN_WIDTH), 1.0) * in_scale
    q_norm = 1.0 + nrm(ks[6], (DEPTH, MLA_Q_RANK), 0.01)
    kv_norm = 1.0 + nrm(ks[7], (DEPTH, MLA_KV_RANK), 0.01)
    w_uq = nrm(ks[8], (DEPTH, MLA_Q_RANK, MLA_HEADS * (MLA_NOPE_DIM + MLA_ROPE_DIM)), MLA_Q_RANK ** -0.5)
    ukv_scale = jnp.tile(jnp.concatenate([jnp.ones((MLA_NOPE_DIM,), f32),
                                          jnp.full((MLA_V_DIM,), DEEPNORM_BETA, f32)]),
                         MLA_HEADS) * (MLA_KV_RANK ** -0.5)
    w_ukv = nrm(ks[9], (DEPTH, MLA_KV_RANK, MLA_HEADS * (MLA_NOPE_DIM + MLA_V_DIM)), 1.0) * ukv_scale
    w_o = nrm(ks[10], (DEPTH, MIX_WIDTH, D_MODEL), MIX_WIDTH ** -0.5 * DEEPNORM_BETA)
    ln1_g = 1.0 + nrm(ks[11], (DEPTH, D_MODEL), 0.01)
    ln1_b = nrm(ks[12], (DEPTH, D_MODEL), 0.01)
    router_w = nrm(ks[13], (D_MODEL, N_EXPERTS), d_in)
    router_bias = nrm(ks[14], (N_EXPERTS,), 0.01)
    w_gate = nrm(ks[15], (DEPTH, N_EXPERTS, D_MODEL, D_EXPERT), d_in * DEEPNORM_BETA)
    w_up = nrm(ks[16], (DEPTH, N_EXPERTS, D_MODEL, D_EXPERT), d_in * DEEPNORM_BETA)
    w_down = nrm(ks[17], (DEPTH, N_EXPERTS, D_EXPERT, D_MODEL), D_EXPERT ** -0.5 * DEEPNORM_BETA)
    ln2_g = 1.0 + nrm(ks[18], (DEPTH, D_MODEL), 0.01)
    ln2_b = nrm(ks[19], (DEPTH, D_MODEL), 0.01)
    return {"x": x, "c": c, "positions": positions, "ada_w": ada_w, "ada_b": ada_b,
            "w_in": w_in, "q_norm": q_norm, "kv_norm": kv_norm, "w_uq": w_uq, "w_ukv": w_ukv,
            "w_o": w_o, "ln1_g": ln1_g, "ln1_b": ln1_b, "router_w": router_w,
            "router_bias": router_bias, "w_gate": w_gate, "w_up": w_up, "w_down": w_down,
            "ln2_g": ln2_g, "ln2_b": ln2_b}


def reference(x, c, positions, ada_w, ada_b, w_in, q_norm, kv_norm, w_uq, w_ukv, w_o,
              ln1_g, ln1_b, router_w, router_bias, w_gate, w_up, w_down, ln2_g, ln2_b):
    cos, sin = rope_tables(positions)
    c_act = jax.nn.silu(c)
    for l in range(DEPTH):
        mod = (c_act @ ada_w[l] + ada_b[l])[:, None, :]
        shift1, scale1, gate1, shift2, scale2, gate2 = jnp.split(mod, 6, axis=-1)
        h = modulate(x, shift1, scale1)
        mix = token_mixer(h, cos, sin, w_in[l], q_norm[l], kv_norm[l], w_uq[l], w_ukv[l], w_o[l])
        x = layer_norm(DEEPNORM_ALPHA * x + (1.0 + gate1) * mix, ln1_g[l], ln1_b[l])
        h = modulate(x, shift2, scale2)
        ffn = moe_ffn(h, router_w, router_bias, w_gate[l], w_up[l], w_down[l])
        x = layer_norm(DEEPNORM_ALPHA * x + (1.0 + gate2) * ffn, ln2_g[l], ln2_b[l])
    return x
```

```cpp
#include <hip/hip_runtime.h>
#include <cstdio>
#include <cstdint>

typedef unsigned short bf16_t;
typedef short bf16x8 __attribute__((ext_vector_type(8)));
typedef float f32x16 __attribute__((ext_vector_type(16)));
typedef float f32x4 __attribute__((ext_vector_type(4)));
typedef float f32x2 __attribute__((ext_vector_type(2)));
typedef unsigned u32x4 __attribute__((ext_vector_type(4)));
typedef unsigned u32x2 __attribute__((ext_vector_type(2)));
typedef __bf16 bf16x2_t __attribute__((ext_vector_type(2)));
#define DI __device__ __forceinline__
#define MFMA(a, b, c) __builtin_amdgcn_mfma_f32_32x32x16_bf16((a), (b), (c), 0, 0, 0)

constexpr int D = 1024, NB = 16, SEQ = 2048, NTOK = NB * SEQ, DEPTH = 2;
constexpr int INW = 1952, INWP = 2048;
constexpr int NEXP = 32, DEXP = 256;
constexpr int LATW = 416;
constexpr float ALPHA = 1.4142135623730951f;
constexpr float LOG2E = 1.4426950408889634f;

constexpr size_t MiB = 1024 * 1024;
constexpr size_t WS_CTL = 0;
constexpr size_t CTL_BYTES = 65536;
constexpr size_t WS_MOD = WS_CTL + CTL_BYTES;
constexpr size_t WS_CS = WS_MOD + (size_t)DEPTH * NB * 6144 * 4;
constexpr size_t WS_BTIN = WS_CS + (size_t)NTOK * 32 * 4;
constexpr size_t WS_BTUQ = WS_BTIN + (size_t)DEPTH * INWP * D * 2;
constexpr size_t WS_BTUKV = WS_BTUQ + (size_t)DEPTH * 768 * 256 * 2;
constexpr size_t WS_BTO = WS_BTUKV + (size_t)DEPTH * 1024 * 128 * 2;
constexpr size_t WS_BTGU = WS_BTO + (size_t)DEPTH * D * D * 2;
constexpr size_t WS_BTD = WS_BTGU + (size_t)DEPTH * NEXP * 512 * D * 2;
constexpr size_t WS_BTR = WS_BTD + (size_t)DEPTH * NEXP * D * DEXP * 2;
constexpr size_t WS_TOKES = WS_BTR + (size_t)128 * D * 2;
constexpr size_t WS_TOKG = WS_TOKES + (size_t)NTOK * 2 * 4;
constexpr size_t WS_LIST = WS_TOKG + (size_t)NTOK * 2 * 4;
constexpr size_t WS_HBUF = WS_LIST + (size_t)NEXP * NTOK * 4;
constexpr size_t WS_REG = WS_HBUF + (size_t)NTOK * D * 2;
constexpr size_t WS_SBQ = WS_REG;
constexpr size_t WS_SBK = WS_SBQ + (size_t)NTOK * 512 * 2;
constexpr size_t WS_SBVT = WS_SBK + (size_t)NTOK * 512 * 2;
constexpr size_t WS_LAT = WS_SBVT + (size_t)NTOK * 512 * 2;
constexpr size_t WS_QM = WS_LAT + (size_t)NTOK * LATW * 2;
constexpr size_t WS_KM = WS_QM + (size_t)NTOK * 768 * 2;
constexpr size_t WS_MVT = WS_KM + (size_t)NTOK * 768 * 2;
constexpr size_t WS_ATT_END = WS_MVT + (size_t)NTOK * 512 * 2;
constexpr size_t WS_X1 = WS_REG;
constexpr size_t WS_YS = WS_X1 + (size_t)NTOK * D * 4;
constexpr size_t WS_ACT = WS_YS + (size_t)2 * NTOK * D * 2;
constexpr size_t WS_FFN_END = WS_ACT + (size_t)2 * NTOK * DEXP * 2;
constexpr size_t WS_END = WS_ATT_END > WS_FFN_END ? WS_ATT_END : WS_FFN_END;

constexpr int CW_ATTQ = 4096;
constexpr int CW_CNT = 4352;
constexpr int CW_BASE = 8448;

constexpr int LSTR = 144;
constexpr int G_STAGE = 256 * LSTR;
constexpr int LDS_AUX = 2 * G_STAGE;
constexpr int LDS_BAR = LDS_AUX + 2048;
constexpr int LDS_BYTES = LDS_BAR + 16;
extern __shared__ __attribute__((aligned(16))) char smem[];

#define XB_TMO      128
#define XB_XCNT(j)  (256  + 64 * (j))
#define XB_XSUB(j)  (1280 + 64 * (j))
#define XB_XGEN(j)  (2304 + 64 * (j))
#define XB_TOP      3328
#define XB_TOPGEN   3392
#define XCD_BAR_WORDS 3456
#define XB_SPIN_CAP (1u << 20)
#define LAS __attribute__((address_space(3)))
DI unsigned xb_ld(unsigned* p)              { return __hip_atomic_load(p, __ATOMIC_RELAXED, __HIP_MEMORY_SCOPE_AGENT); }
DI unsigned xb_add(unsigned* p, unsigned v) { return __hip_atomic_fetch_add(p, v, __ATOMIC_RELAXED, __HIP_MEMORY_SCOPE_AGENT); }
DI unsigned xb_xcc_id() { return (unsigned)__builtin_amdgcn_s_getreg((3 << 11) | 20) & 0xFu; }
#define XB_SPIN(cond, bar) do { unsigned _sp = 0; while (cond) { __builtin_amdgcn_s_sleep(1); \
    if ((++_sp & 255u) == 0u) { if (xb_ld(&(bar)[XB_TMO])) break; if (_sp > XB_SPIN_CAP) { atomicAdd(&(bar)[XB_TMO], 1u); break; } } } } while (0)
struct XcdBarrier { unsigned* bar; unsigned x; volatile LAS unsigned* st; };
DI XcdBarrier xcd_barrier_post(unsigned* bar, volatile LAS unsigned* st) {
    XcdBarrier b; b.bar = bar; b.x = xb_xcc_id(); b.st = st;
    if (threadIdx.x == 0) (void)xb_add(&bar[XB_XCNT(b.x)], 1u);
    return b;
}
DI void xcd_barrier_complete(unsigned* bar, unsigned x, unsigned& nloc, unsigned& nx) {
    const unsigned G = gridDim.x * gridDim.y * gridDim.z;
    unsigned sum, cnt, mine, sp = 0u;
    for (;;) {
        sum = 0u; cnt = 0u; mine = 0u;
#pragma unroll
        for (unsigned j = 0; j < 16; ++j) { const unsigned c = xb_ld(&bar[XB_XCNT(j)]); sum += c; cnt += (c > 0u) ? 1u : 0u; mine = (j == x) ? c : mine; }
        if (sum == G) break;
        __builtin_amdgcn_s_sleep(1);
        if ((++sp & 255u) == 0u) { if (xb_ld(&bar[XB_TMO])) break; if (sp > XB_SPIN_CAP) { atomicAdd(&bar[XB_TMO], 1u); break; } }
    }
    nloc = mine > 0u ? mine : 1u; nx = cnt > 0u ? cnt : 1u;
}
DI void xcd_barrier(const XcdBarrier& b) {
    asm volatile("s_waitcnt vmcnt(0)" ::: "memory");
    __syncthreads();
    if (threadIdx.x == 0) {
        unsigned* bar = b.bar;
        __builtin_amdgcn_s_waitcnt(0);
        unsigned nloc = b.st[0], nx = b.st[1];
        if (nloc == 0u) { xcd_barrier_complete(bar, b.x, nloc, nx); b.st[0] = nloc; b.st[1] = nx; }
        const unsigned old = xb_add(&bar[XB_XSUB(b.x)], 1u);
        const unsigned gen = old / nloc;
        if (old + 1u == (gen + 1u) * nloc) {
            __builtin_amdgcn_fence(__ATOMIC_RELEASE, "agent");
            asm volatile("s_waitcnt vmcnt(0)" ::: "memory");
            const unsigned og = xb_add(&bar[XB_TOP], 1u);
            const unsigned tg = og / nx;
            if (og + 1u == (tg + 1u) * nx) xb_add(&bar[XB_TOPGEN], 1u);
            else XB_SPIN(xb_ld(&bar[XB_TOPGEN]) == tg, bar);
            __builtin_amdgcn_fence(__ATOMIC_ACQUIRE, "agent");
            xb_add(&bar[XB_XGEN(b.x)], 1u);
            asm volatile("s_waitcnt vmcnt(0)" ::: "memory");
        } else {
            XB_SPIN(xb_ld(&bar[XB_XGEN(b.x)]) == gen, bar);
            __builtin_amdgcn_fence(__ATOMIC_ACQUIRE, "agent");
            asm volatile("s_waitcnt vmcnt(0)" ::: "memory");
        }
    }
    __syncthreads();
}

DI float bf2f(unsigned v16) { return __uint_as_float(v16 << 16); }
DI unsigned cvtpk(float lo, float hi) { f32x2 v = {lo, hi}; bf16x2_t b = __builtin_convertvector(v, bf16x2_t); return __builtin_bit_cast(unsigned, b); }
DI int crow(int i, int h) { return (i & 3) + 8 * (i >> 2) + 4 * h; }
DI float wsum(float v) {
#pragma unroll
    for (int o = 32; o; o >>= 1) v += __shfl_xor(v, o);
    return v;
}
DI float xhalf(float v) {
    const unsigned mine = __float_as_uint(v);
    auto rr = __builtin_amdgcn_permlane32_swap(mine, mine, false, false);
    const unsigned a = rr[0], b = rr[1];
    return __uint_as_float(a == mine ? b : a);
}
DI int xhalf_i(int v) {
    const unsigned mine = (unsigned)v;
    auto rr = __builtin_amdgcn_permlane32_swap(mine, mine, false, false);
    const unsigned a = rr[0], b = rr[1];
    return (int)(a == mine ? b : a);
}
DI int otid() { int t = threadIdx.x; asm volatile("" : "+v"(t)); return t; }
DI float fexp2(float x) { return __builtin_amdgcn_exp2f(x); }
DI float flog2(float x) { return __builtin_amdgcn_logf(x); }
DI float frcp(float x) { return __builtin_amdgcn_rcpf(x); }
DI float sigmoidf_(float x) { return frcp(1.0f + fexp2(-x * LOG2E)); }

struct Params {
    const float *x, *c; const int* pos;
    const float *ada_w, *ada_b, *w_in, *q_norm, *kv_norm, *w_uq, *w_ukv, *w_o, *ln1_g, *ln1_b, *router_w, *router_bias, *w_gate, *w_up, *w_down, *ln2_g, *ln2_b;
    float* out; unsigned char* ws;
};

template <bool SWAP, bool SUMSQ, class ARow, class Epi>
DI void gemm_tile(const ARow& arow, const bf16_t* __restrict__ Bt, const int K, const Epi& epi) {
    const int tid = otid(), lane = tid & 63, wid = __builtin_amdgcn_readfirstlane(tid >> 6), wr = wid >> 1, wc = wid & 1, r32 = lane & 31, hh = lane >> 5;
    const int lc = tid & 7, lr = tid >> 3;
    const bf16_t* ap[4]; const bf16_t* bp[4];
#pragma unroll
    for (int i = 0; i < 4; ++i) { ap[i] = arow(lr + 32 * i) + lc * 8; bp[i] = Bt + (size_t)(lr + 32 * i) * K + lc * 8; }
    u32x4 ra[4], rb[4];
    float ss[4] = {0.f, 0.f, 0.f, 0.f};
    f32x16 acc[2][2];
#pragma unroll
    for (int a = 0; a < 2; ++a)
#pragma unroll
        for (int b = 0; b < 2; ++b)
#pragma unroll
            for (int i = 0; i < 16; ++i) acc[a][b][i] = 0.f;
    const int KT = K >> 6;
    auto gload = [&](int kt) {
#pragma unroll
        for (int i = 0; i < 4; ++i) { ra[i] = *(const u32x4*)(ap[i] + kt * 64); rb[i] = *(const u32x4*)(bp[i] + kt * 64); }
        if (SUMSQ) {
#pragma unroll
            for (int i = 0; i < 4; ++i)
#pragma unroll
                for (int j = 0; j < 4; ++j) { const float lo = bf2f(ra[i][j] & 0xffffu), hi = bf2f(ra[i][j] >> 16); ss[i] += lo * lo + hi * hi; }
        }
    };
    auto lstore = [&](int buf) {
        char* base = smem + buf * G_STAGE;
#pragma unroll
        for (int i = 0; i < 4; ++i) {
            *(u32x4*)(base + (lr + 32 * i) * LSTR + lc * 16) = ra[i];
            *(u32x4*)(base + (128 + lr + 32 * i) * LSTR + lc * 16) = rb[i];
        }
    };
    gload(0); lstore(0); __syncthreads();
    for (int kt = 0; kt < KT; ++kt) {
        const int cur = kt & 1;
        if (kt + 1 < KT) gload(kt + 1);
        const char* base = smem + cur * G_STAGE;
#pragma unroll
        for (int ks = 0; ks < 4; ++ks) {
            bf16x8 af[2], bfr[2];
#pragma unroll
            for (int mb = 0; mb < 2; ++mb) af[mb] = *(const bf16x8*)(base + (wr * 64 + mb * 32 + r32) * LSTR + ks * 32 + hh * 16);
#pragma unroll
            for (int nb = 0; nb < 2; ++nb) bfr[nb] = *(const bf16x8*)(base + (128 + wc * 64 + nb * 32 + r32) * LSTR + ks * 32 + hh * 16);
#pragma unroll
            for (int mb = 0; mb < 2; ++mb)
#pragma unroll
                for (int nb = 0; nb < 2; ++nb)
                    acc[mb][nb] = SWAP ? MFMA(bfr[nb], af[mb], acc[mb][nb]) : MFMA(af[mb], bfr[nb], acc[mb][nb]);
        }
        if (kt + 1 < KT) lstore(cur ^ 1);
        __syncthreads();
    }
    if (SUMSQ) {
        float* rowss = (float*)(smem + LDS_AUX);
#pragma unroll
        for (int i = 0; i < 4; ++i) {
            float s = ss[i];
            s += __shfl_xor(s, 1); s += __shfl_xor(s, 2); s += __shfl_xor(s, 4);
            if (lc == 0) rowss[lr + 32 * i] = s;
        }
        __syncthreads();
    }
    epi(acc, wr, wc, r32, hh);
}

DI void conv_tile(const float* src, const float* src2, const float* kscale, bf16_t* dst, int N, int K, int nvalid, int mode, int k0, int n0p) {
    const int tid = otid(), nn = tid & 63, kq = tid >> 6;
    const int np = n0p + nn;
    const float* s = src; int col;
    if (mode == 0) col = np < nvalid ? np : -1;
    else if (mode == 1) col = np < 512 ? ((np >> 6) * 128 + (np & 63)) : (((np - 512) >> 6) * 128 + 64 + (np & 63));
    else { col = (np >> 7) * 64 + ((np >> 6) & 1) * 32 + (np & 31); s = ((np >> 5) & 1) ? src2 : src; }
    bf16_t* tl = (bf16_t*)smem;
#pragma unroll
    for (int i = 0; i < 16; ++i) {
        const int kk = kq + 4 * i;
        float v = 0.f;
        if (col >= 0) v = s[(size_t)(k0 + kk) * N + col];
        if (kscale) v *= kscale[k0 + kk];
        tl[nn * 72 + kk] = (bf16_t)(cvtpk(v, 0.f) & 0xffffu);
    }
    __syncthreads();
#pragma unroll
    for (int i = 0; i < 2; ++i) {
        const int row = (tid >> 3) + 32 * i, ch = tid & 7;
        *(u32x4*)(dst + (size_t)(n0p + row) * K + k0 + ch * 8) = *(const u32x4*)((const char*)tl + row * 144 + ch * 16);
    }
    __syncthreads();
}

DI void phase0(const Params& p) {
    unsigned char* ws = p.ws;
    const int tid = otid();
    constexpr int N_MOD = 2 * 96, N_CS = NTOK / 256;
    constexpr int T_IN = 2 * 32 * 16, T_UQ = 2 * 12 * 4, T_UKV = 2 * 16 * 2, T_O = 2 * 16 * 16, T_GU = 64 * 8 * 16, T_D = 64 * 16 * 4, T_R = 2 * 16;
    constexpr int O1 = N_MOD, O2 = O1 + N_CS, O3 = O2 + T_IN, O4 = O3 + T_UQ, O5 = O4 + T_UKV, O6 = O5 + T_O, O7 = O6 + T_GU, O8 = O7 + T_D, TOTAL = O8 + T_R;
    for (int it = blockIdx.x; it < TOTAL; it += gridDim.x) {
        if (it < O1) {
            const int l = it / 96, n0 = (it % 96) * 64;
            float* sc = (float*)smem;
            for (int i = tid; i < NB * D; i += 256) { const float v = p.c[i]; sc[i] = v * sigmoidf_(v); }
            __syncthreads();
            const int n = tid & 63, kq = tid >> 6;
            float acc[16];
#pragma unroll
            for (int b = 0; b < 16; ++b) acc[b] = 0.f;
            const float* wp = p.ada_w + (size_t)l * D * 6144 + n0 + n;
            for (int k = kq * 256; k < kq * 256 + 256; ++k) {
                const float w = wp[(size_t)k * 6144];
#pragma unroll
                for (int b = 0; b < 16; ++b) acc[b] += sc[b * D + k] * w;
            }
            __syncthreads();
            float* part = (float*)smem;
#pragma unroll
            for (int b = 0; b < 16; ++b) part[(kq * 16 + b) * 64 + n] = acc[b];
            __syncthreads();
            for (int i = tid; i < 16 * 64; i += 256) {
                const int b = i >> 6, nn = i & 63;
                const float v = part[(0 * 16 + b) * 64 + nn] + part[(1 * 16 + b) * 64 + nn] + part[(2 * 16 + b) * 64 + nn] + part[(3 * 16 + b) * 64 + nn];
                ((float*)(ws + WS_MOD))[((size_t)l * NB + b) * 6144 + n0 + nn] = v + p.ada_b[(size_t)l * 6144 + n0 + nn];
            }
            __syncthreads();
        } else if (it < O2) {
            const int t = (it - O1) * 256 + tid;
            const float posf = (float)p.pos[t];
            float* cs = (float*)(ws + WS_CS) + (size_t)t * 32;
#pragma unroll
            for (int i = 0; i < 16; ++i) {
                const float inv = (float)exp2(-(double)i * (13.287712379549449 / 16.0));
                const float ang = posf * inv;
                const double rev = (double)ang * 0.15915494309189535;
                const float fr = (float)(rev - rint(rev));
                cs[i] = __builtin_amdgcn_cosf(fr);
                cs[16 + i] = __builtin_amdgcn_sinf(fr);
            }
        } else if (it < O3) {
            const int t = it - O2, l = t / 512, r = t % 512, nt = r / 16, kt = r % 16;
            conv_tile(p.w_in + (size_t)l * D * INW, nullptr, nullptr, (bf16_t*)(ws + WS_BTIN) + (size_t)l * INWP * D, INW, D, INW, 0, kt * 64, nt * 64);
        } else if (it < O4) {
            const int t = it - O3, l = t / 48, r = t % 48, nt = r / 4, kt = r % 4;
            conv_tile(p.w_uq + (size_t)l * 256 * 768, nullptr, p.q_norm + l * 256, (bf16_t*)(ws + WS_BTUQ) + (size_t)l * 768 * 256, 768, 256, 768, 0, kt * 64, nt * 64);
        } else if (it < O5) {
            const int t = it - O4, l = t / 32, r = t % 32, nt = r / 2, kt = r % 2;
            conv_tile(p.w_ukv + (size_t)l * 128 * 1024, nullptr, p.kv_norm + l * 128, (bf16_t*)(ws + WS_BTUKV) + (size_t)l * 1024 * 128, 1024, 128, 1024, 1, kt * 64, nt * 64);
        } else if (it < O6) {
            const int t = it - O5, l = t / 256, r = t % 256, nt = r / 16, kt = r % 16;
            conv_tile(p.w_o + (size_t)l * D * D, nullptr, nullptr, (bf16_t*)(ws + WS_BTO) + (size_t)l * D * D, D, D, D, 0, kt * 64, nt * 64);
        } else if (it < O7) {
            const int t = it - O6, le = t / 128, r = t % 128, nt = r / 16, kt = r % 16;
            conv_tile(p.w_gate + (size_t)le * D * DEXP, p.w_up + (size_t)le * D * DEXP, nullptr, (bf16_t*)(ws + WS_BTGU) + (size_t)le * 512 * D, DEXP, D, 512, 2, kt * 64, nt * 64);
        } else if (it < O8) {
            const int t = it - O7, le = t / 64, r = t % 64, nt = r / 4, kt = r % 4;
            conv_tile(p.w_down + (size_t)le * DEXP * D, nullptr, nullptr, (bf16_t*)(ws + WS_BTD) + (size_t)le * D * DEXP, D, DEXP, D, 0, kt * 64, nt * 64);
        } else {
            const int t = it - O8, nt = t / 16, kt = t % 16;
            conv_tile(p.router_w, nullptr, nullptr, (bf16_t*)(ws + WS_BTR), NEXP, D, NEXP, 0, kt * 64, nt * 64);
        }
    }
}

DI void row_stats(const f32x4 (&v)[4], float& mu, float& rstd) {
    float s = 0.f;
#pragma unroll
    for (int i = 0; i < 4; ++i) s += (v[i][0] + v[i][1]) + (v[i][2] + v[i][3]);
    mu = wsum(s) * (1.0f / D);
    float q = 0.f;
#pragma unroll
    for (int i = 0; i < 4; ++i)
#pragma unroll
        for (int j = 0; j < 4; ++j) { const float d = v[i][j] - mu; q += d * d; }
    rstd = __builtin_amdgcn_rsqf(wsum(q) * (1.0f / D) + 1e-5f);
}
DI void modulate_store(const f32x4 (&v)[4], const float* shift, const float* scale, bf16_t* hrow, int lane) {
    float mu, rstd; row_stats(v, mu, rstd);
#pragma unroll
    for (int i = 0; i < 4; ++i) {
        const int c0 = 256 * i + 4 * lane;
        const f32x4 sh = *(const f32x4*)(shift + c0), sc = *(const f32x4*)(scale + c0);
        float o[4];
#pragma unroll
        for (int j = 0; j < 4; ++j) o[j] = (v[i][j] - mu) * rstd * (1.0f + sc[j]) + sh[j];
        u32x2 w; w.x = cvtpk(o[0], o[1]); w.y = cvtpk(o[2], o[3]);
        *(u32x2*)(hrow + c0) = w;
    }
}

DI void phase_ln0(const Params& p) {
    const int tid_ = otid(), lane = tid_ & 63, gw = blockIdx.x * 4 + (tid_ >> 6), nw = gridDim.x * 4;
    const float* mod = (const float*)(p.ws + WS_MOD);
    bf16_t* hb = (bf16_t*)(p.ws + WS_HBUF);
    for (int row = gw; row < NTOK; row += nw) {
        const int b = row / SEQ;
        f32x4 v[4];
#pragma unroll
        for (int i = 0; i < 4; ++i) v[i] = *(const f32x4*)(p.x + (size_t)row * D + 256 * i + 4 * lane);
        modulate_store(v, mod + (size_t)b * 6144, mod + (size_t)b * 6144 + 1024, hb + (size_t)row * D, lane);
    }
}

DI void phase_ln1(const Params& p, int l) {
    const int tid_ = otid(), lane = tid_ & 63, gw = blockIdx.x * 4 + (tid_ >> 6), nw = gridDim.x * 4;
    const float* mod = (const float*)(p.ws + WS_MOD) + (size_t)l * NB * 6144;
    float* x1 = (float*)(p.ws + WS_X1);
    bf16_t* hb = (bf16_t*)(p.ws + WS_HBUF);
    const float* g = p.ln1_g + l * D; const float* be = p.ln1_b + l * D;
    for (int row = gw; row < NTOK; row += nw) {
        const int b = row / SEQ;
        f32x4 v[4];
#pragma unroll
        for (int i = 0; i < 4; ++i) v[i] = *(const f32x4*)(x1 + (size_t)row * D + 256 * i + 4 * lane);
        float mu, rstd; row_stats(v, mu, rstd);
#pragma unroll
        for (int i = 0; i < 4; ++i) {
            const int c0 = 256 * i + 4 * lane;
            const f32x4 gg = *(const f32x4*)(g + c0), bb = *(const f32x4*)(be + c0);
#pragma unroll
            for (int j = 0; j < 4; ++j) v[i][j] = (v[i][j] - mu) * rstd * gg[j] + bb[j];
            *(f32x4*)(x1 + (size_t)row * D + c0) = v[i];
        }
        modulate_store(v, mod + (size_t)b * 6144 + 3072, mod + (size_t)b * 6144 + 4096, hb + (size_t)row * D, lane);
    }
}

DI void phase_ln2(const Params& p, int l, float* xout) {
    const int tid_ = otid(), lane = tid_ & 63, gw = blockIdx.x * 4 + (tid_ >> 6), nw = gridDim.x * 4;
    const float* mod = (const float*)(p.ws + WS_MOD) + (size_t)l * NB * 6144;
    const float* x1 = (const float*)(p.ws + WS_X1);
    const bf16_t* ys = (const bf16_t*)(p.ws + WS_YS);
    const int* tes = (const int*)(p.ws + WS_TOKES);
    const float* tg = (const float*)(p.ws + WS_TOKG);
    const unsigned* ebase = (const unsigned*)(p.ws + WS_CTL) + CW_BASE + l * 64;
    bf16_t* hb = (bf16_t*)(p.ws + WS_HBUF);
    const float* g = p.ln2_g + l * D; const float* be = p.ln2_b + l * D;
    for (int row = gw; row < NTOK; row += nw) {
        const int b = row / SEQ;
        const int es0 = tes[row * 2], es1 = tes[row * 2 + 1];
        const float g0 = tg[row * 2], g1 = tg[row * 2 + 1];
        const size_t pos0 = (size_t)ebase[es0 >> 24] + (es0 & 0xffffff), pos1 = (size_t)ebase[es1 >> 24] + (es1 & 0xffffff);
        const float* gate2 = mod + (size_t)b * 6144 + 5120;
        f32x4 v[4];
#pragma unroll
        for (int i = 0; i < 4; ++i) {
            const int c0 = 256 * i + 4 * lane;
            const f32x4 xv = *(const f32x4*)(x1 + (size_t)row * D + c0);
            const u32x2 y0 = *(const u32x2*)(ys + pos0 * D + c0), y1 = *(const u32x2*)(ys + pos1 * D + c0);
            const f32x4 gt = *(const f32x4*)(gate2 + c0);
            float f[4];
            f[0] = g0 * bf2f(y0.x & 0xffffu) + g1 * bf2f(y1.x & 0xffffu);
            f[1] = g0 * bf2f(y0.x >> 16) + g1 * bf2f(y1.x >> 16);
            f[2] = g0 * bf2f(y0.y & 0xffffu) + g1 * bf2f(y1.y & 0xffffu);
            f[3] = g0 * bf2f(y0.y >> 16) + g1 * bf2f(y1.y >> 16);
#pragma unroll
            for (int j = 0; j < 4; ++j) v[i][j] = ALPHA * xv[j] + (1.0f + gt[j]) * f[j];
        }
        float mu, rstd; row_stats(v, mu, rstd);
#pragma unroll
        for (int i = 0; i < 4; ++i) {
            const int c0 = 256 * i + 4 * lane;
            const f32x4 gg = *(const f32x4*)(g + c0), bb = *(const f32x4*)(be + c0);
#pragma unroll
            for (int j = 0; j < 4; ++j) v[i][j] = (v[i][j] - mu) * rstd * gg[j] + bb[j];
            *(f32x4*)(xout + (size_t)row * D + c0) = v[i];
        }
        if (l + 1 < DEPTH) {
            const float* modn = (const float*)(p.ws + WS_MOD) + (size_t)(l + 1) * NB * 6144;
            modulate_store(v, modn + (size_t)b * 6144, modn + (size_t)b * 6144 + 1024, hb + (size_t)row * D, lane);
        }
    }
}

DI void st4bf(bf16_t* pz, float a, float b, float c, float d) { u32x2 w; w.x = cvtpk(a, b); w.y = cvtpk(c, d); *(u32x2*)pz = w; }
DI void st8bf(bf16_t* pz, const f32x16& v, int o) { u32x4 w; w.x = cvtpk(v[o], v[o + 1]); w.y = cvtpk(v[o + 2], v[o + 3]); w.z = cvtpk(v[o + 4], v[o + 5]); w.w = cvtpk(v[o + 6], v[o + 7]); *(u32x4*)pz = w; }

DI void phase_gemm1(const Params& p, int l) {
    unsigned char* ws = p.ws;
    const bf16_t* hb = (const bf16_t*)(ws + WS_HBUF);
    const bf16_t* bt = (const bf16_t*)(ws + WS_BTIN) + (size_t)l * INWP * D;
    bf16_t* sbq = (bf16_t*)(ws + WS_SBQ); bf16_t* sbk = (bf16_t*)(ws + WS_SBK); bf16_t* sbvt = (bf16_t*)(ws + WS_SBVT); bf16_t* lat = (bf16_t*)(ws + WS_LAT);
    constexpr int NTL = (NTOK / 128) * 16;
    for (int t = blockIdx.x; t < NTL; t += gridDim.x) {
        const int mt = t >> 4, nt = t & 15, m0 = mt * 128, n0 = nt * 128;
        auto arow = [&](int r) { return hb + (size_t)(m0 + r) * D; };
        if (n0 >= 1024 && n0 < 1536) {
            const int b = m0 / SEQ, s0 = m0 % SEQ;
            auto epi = [&](const f32x16 (&acc)[2][2], int wr, int wc, int r32, int hh) {
                const int head = ((n0 - 1024) >> 6) + wc;
#pragma unroll
                for (int mb = 0; mb < 2; ++mb)
#pragma unroll
                    for (int nb = 0; nb < 2; ++nb) {
                        bf16_t* dst = sbvt + ((size_t)(b * 8 + head) * 64 + nb * 32 + r32) * SEQ + s0 + wr * 64 + mb * 32 + 8 * hh;
                        st8bf(dst, acc[mb][nb], 0); st8bf(dst + 16, acc[mb][nb], 8);
                    }
            };
            gemm_tile<false, false>(arow, bt + (size_t)n0 * D, D, epi);
        } else {
            auto epi = [&](const f32x16 (&acc)[2][2], int wr, int wc, int r32, int hh) {
#pragma unroll
                for (int mb = 0; mb < 2; ++mb) {
                    const size_t tok = (size_t)m0 + wr * 64 + mb * 32 + r32;
#pragma unroll
                    for (int nb = 0; nb < 2; ++nb) {
                        const int cb = n0 + wc * 64 + nb * 32 + 4 * hh;
#pragma unroll
                        for (int g = 0; g < 4; ++g) {
                            const int c = cb + 8 * g;
                            const float a0 = acc[mb][nb][4 * g], a1 = acc[mb][nb][4 * g + 1], a2 = acc[mb][nb][4 * g + 2], a3 = acc[mb][nb][4 * g + 3];
                            if (n0 < 512) { const float sc = 0.125f * LOG2E; st4bf(sbq + tok * 512 + c, a0 * sc, a1 * sc, a2 * sc, a3 * sc); }
                            else if (n0 < 1024) st4bf(sbk + tok * 512 + (c - 512), a0, a1, a2, a3);
                            else if (c < INW) st4bf(lat + tok * LATW + (c - 1536), a0, a1, a2, a3);
                        }
                    }
                }
            };
            gemm_tile<true, false>(arow, bt + (size_t)n0 * D, D, epi);
        }
    }
}

DI void phase_mlaprep(const Params& p, int l) {
    unsigned char* ws = p.ws;
    const bf16_t* lat = (const bf16_t*)(ws + WS_LAT);
    const bf16_t* btq = (const bf16_t*)(ws + WS_BTUQ) + (size_t)l * 768 * 256;
    const bf16_t* btkv = (const bf16_t*)(ws + WS_BTUKV) + (size_t)l * 1024 * 128;
    bf16_t* qm = (bf16_t*)(ws + WS_QM); bf16_t* km = (bf16_t*)(ws + WS_KM); bf16_t* mvt = (bf16_t*)(ws + WS_MVT);
    const float* cs = (const float*)(ws + WS_CS);
    const float* rowss = (const float*)(smem + LDS_AUX);
    constexpr int NTL = (NTOK / 128) * 14;
    for (int t = blockIdx.x; t < NTL; t += gridDim.x) {
        const int mt = t / 14, j = t % 14, m0 = mt * 128;
        if (j < 6) {
            const int n0 = j * 128;
            auto arow = [&](int r) { return lat + (size_t)(m0 + r) * LATW; };
            auto epi = [&](const f32x16 (&acc)[2][2], int wr, int wc, int r32, int hh) {
                const float qs = 0.10206207261596575f * LOG2E;
#pragma unroll
                for (int mb = 0; mb < 2; ++mb) {
                    const int tl = wr * 64 + mb * 32 + r32;
                    const size_t tok = (size_t)m0 + tl;
                    const float rs = __builtin_amdgcn_rsqf(rowss[tl] * (1.0f / 256.0f) + 1e-6f) * qs;
#pragma unroll
                    for (int nb = 0; nb < 2; ++nb) {
                        const int cb = n0 + wc * 64 + nb * 32;
                        float v[16];
#pragma unroll
                        for (int i = 0; i < 16; ++i) v[i] = acc[mb][nb][i] * rs;
                        if ((cb % 96) == 64) {
                            const f32x4 c0 = *(const f32x4*)(cs + tok * 32 + 4 * hh), c1 = *(const f32x4*)(cs + tok * 32 + 8 + 4 * hh);
                            const f32x4 s0 = *(const f32x4*)(cs + tok * 32 + 16 + 4 * hh), s1 = *(const f32x4*)(cs + tok * 32 + 24 + 4 * hh);
#pragma unroll
                            for (int i = 0; i < 8; ++i) {
                                const float cc = i < 4 ? c0[i & 3] : c1[i & 3], sn = i < 4 ? s0[i & 3] : s1[i & 3];
                                const float t1 = v[i], t2 = v[i + 8];
                                v[i] = t1 * cc - t2 * sn; v[i + 8] = t1 * sn + t2 * cc;
                            }
                        }
#pragma unroll
                        for (int g = 0; g < 4; ++g) st4bf(qm + tok * 768 + cb + 8 * g + 4 * hh, v[4 * g], v[4 * g + 1], v[4 * g + 2], v[4 * g + 3]);
                    }
                }
            };
            gemm_tile<true, true>(arow, btq + (size_t)n0 * 256, 256, epi);
        } else if (j < 10) {
            const int n0 = (j - 6) * 128;
            auto arow = [&](int r) { return lat + (size_t)(m0 + r) * LATW + 256; };
            auto epi = [&](const f32x16 (&acc)[2][2], int wr, int wc, int r32, int hh) {
                const int head = (n0 >> 6) + wc;
#pragma unroll
                for (int mb = 0; mb < 2; ++mb) {
                    const int tl = wr * 64 + mb * 32 + r32;
                    const size_t tok = (size_t)m0 + tl;
                    const float rs = __builtin_amdgcn_rsqf(rowss[tl] * (1.0f / 128.0f) + 1e-6f);
                    bf16_t* krow = km + (tok * 8 + head) * 96;
#pragma unroll
                    for (int nb = 0; nb < 2; ++nb)
#pragma unroll
                        for (int g = 0; g < 4; ++g)
                            st4bf(krow + nb * 32 + 8 * g + 4 * hh, acc[mb][nb][4 * g] * rs, acc[mb][nb][4 * g + 1] * rs, acc[mb][nb][4 * g + 2] * rs, acc[mb][nb][4 * g + 3] * rs);
                    const u32x4 r1 = *(const u32x4*)(lat + tok * LATW + 384 + 8 * hh), r2 = *(const u32x4*)(lat + tok * LATW + 400 + 8 * hh);
                    const f32x4 c0 = *(const f32x4*)(cs + tok * 32 + 8 * hh), c1 = *(const f32x4*)(cs + tok * 32 + 8 * hh + 4);
                    const f32x4 s0 = *(const f32x4*)(cs + tok * 32 + 16 + 8 * hh), s1 = *(const f32x4*)(cs + tok * 32 + 16 + 8 * hh + 4);
                    float o1[8], o2[8];
#pragma unroll
                    for (int i = 0; i < 8; ++i) {
                        const float t1 = (i & 1) ? bf2f(r1[i >> 1] >> 16) : bf2f(r1[i >> 1] & 0xffffu);
                        const float t2 = (i & 1) ? bf2f(r2[i >> 1] >> 16) : bf2f(r2[i >> 1] & 0xffffu);
                        const float cc = i < 4 ? c0[i & 3] : c1[i & 3], sn = i < 4 ? s0[i & 3] : s1[i & 3];
                        o1[i] = t1 * cc - t2 * sn; o2[i] = t1 * sn + t2 * cc;
                    }
                    u32x4 w1, w2;
                    w1.x = cvtpk(o1[0], o1[1]); w1.y = cvtpk(o1[2], o1[3]); w1.z = cvtpk(o1[4], o1[5]); w1.w = cvtpk(o1[6], o1[7]);
                    w2.x = cvtpk(o2[0], o2[1]); w2.y = cvtpk(o2[2], o2[3]); w2.z = cvtpk(o2[4], o2[5]); w2.w = cvtpk(o2[6], o2[7]);
                    *(u32x4*)(krow + 64 + 8 * hh) = w1; *(u32x4*)(krow + 80 + 8 * hh) = w2;
                }
            };
            gemm_tile<true, true>(arow, btkv + (size_t)n0 * 128, 128, epi);
        } else {
            const int n0 = 512 + (j - 10) * 128;
            const int b = m0 / SEQ, s0 = m0 % SEQ;
            auto arow = [&](int r) { return lat + (size_t)(m0 + r) * LATW + 256; };
            auto epi = [&](const f32x16 (&acc)[2][2], int wr, int wc, int r32, int hh) {
                const int head = ((n0 - 512) >> 6) + wc;
#pragma unroll
                for (int mb = 0; mb < 2; ++mb) {
                    f32x16 sc;
#pragma unroll
                    for (int i = 0; i < 16; ++i) sc[i] = __builtin_amdgcn_rsqf(rowss[wr * 64 + mb * 32 + crow(i, hh)] * (1.0f / 128.0f) + 1e-6f);
#pragma unroll
                    for (int nb = 0; nb < 2; ++nb) {
                        f32x16 v;
#pragma unroll
                        for (int i = 0; i < 16; ++i) v[i] = acc[mb][nb][i] * sc[i];
                        bf16_t* dst = mvt + ((size_t)(b * 8 + head) * 64 + nb * 32 + r32) * SEQ + s0 + wr * 64 + mb * 32 + 8 * hh;
                        st8bf(dst, v, 0); st8bf(dst + 16, v, 8);
                    }
                }
            };
            gemm_tile<false, true>(arow, btkv + (size_t)n0 * 128, 128, epi);
        }
    }
}

DI void phase_wo(const Params& p, int l, const float* xin) {
    unsigned char* ws = p.ws;
    const bf16_t* mg = (const bf16_t*)(ws + WS_HBUF);
    const bf16_t* bt = (const bf16_t*)(ws + WS_BTO) + (size_t)l * D * D;
    const float* mod = (const float*)(ws + WS_MOD) + (size_t)l * NB * 6144;
    float* t1 = (float*)(ws + WS_X1);
    constexpr int NTL = (NTOK / 128) * 8;
    for (int t = blockIdx.x; t < NTL; t += gridDim.x) {
        const int mt = t >> 3, nt = t & 7, m0 = mt * 128, n0 = nt * 128;
        const float* gate1 = mod + (size_t)(m0 / SEQ) * 6144 + 2048;
        auto arow = [&](int r) { return mg + (size_t)(m0 + r) * D; };
        auto epi = [&](const f32x16 (&acc)[2][2], int wr, int wc, int r32, int hh) {
#pragma unroll
            for (int mb = 0; mb < 2; ++mb) {
                const size_t tok = (size_t)m0 + wr * 64 + mb * 32 + r32;
#pragma unroll
                for (int nb = 0; nb < 2; ++nb)
#pragma unroll
                    for (int g = 0; g < 4; ++g) {
                        const int c = n0 + wc * 64 + nb * 32 + 8 * g + 4 * hh;
                        const f32x4 xv = *(const f32x4*)(xin + tok * D + c), gt = *(const f32x4*)(gate1 + c);
                        f32x4 o;
#pragma unroll
                        for (int jj = 0; jj < 4; ++jj) o[jj] = ALPHA * xv[jj] + (1.0f + gt[jj]) * acc[mb][nb][4 * g + jj];
                        *(f32x4*)(t1 + tok * D + c) = o;
                    }
            }
        };
        gemm_tile<true, false>(arow, bt + (size_t)n0 * D, D, epi);
    }
}

DI void phase_router(const Params& p, int l) {
    unsigned char* ws = p.ws;
    const bf16_t* hb = (const bf16_t*)(ws + WS_HBUF);
    const bf16_t* bt = (const bf16_t*)(ws + WS_BTR);
    unsigned* cnt = (unsigned*)(ws + WS_CTL) + CW_CNT + l * 2048;
    int* tes = (int*)(ws + WS_TOKES); float* tg = (float*)(ws + WS_TOKG); int* list = (int*)(ws + WS_LIST);
    unsigned* hist = (unsigned*)(smem + LDS_AUX + 1024);
    constexpr int NTL = NTOK / 128;
    for (int t = blockIdx.x; t < NTL; t += gridDim.x) {
        const int m0 = t * 128;
        if (threadIdx.x < 32) hist[threadIdx.x] = 0u;
        auto arow = [&](int r) { return hb + (size_t)(m0 + r) * D; };
        auto epi = [&](const f32x16 (&acc)[2][2], int wr, int wc, int r32, int hh) {
            int e0[2], e1[2], ls0[2], ls1[2]; float ga[2], gb[2]; bool own[2];
#pragma unroll
            for (int mb = 0; mb < 2; ++mb) {
                own[mb] = false; e0[mb] = e1[mb] = 0; ls0[mb] = ls1[mb] = 0; ga[mb] = gb[mb] = 0.f;
                if (wc == 0) {
                    float sc[16], bs[16];
#pragma unroll
                    for (int i = 0; i < 16; ++i) { sc[i] = sigmoidf_(acc[mb][0][i]); bs[i] = sc[i] + p.router_bias[crow(i, hh)]; }
                    float best = -1e30f; int bg = 0;
#pragma unroll
                    for (int g = 0; g < 4; ++g) {
                        const float a = bs[4 * g], b = bs[4 * g + 1], c = bs[4 * g + 2], d = bs[4 * g + 3];
                        const float h1 = fmaxf(a, b), l1 = fminf(a, b), h2 = fmaxf(c, d), l2 = fminf(c, d);
                        const float gs = fmaxf(h1, h2) + fmaxf(fminf(h1, h2), fmaxf(l1, l2));
                        if (gs > best) { best = gs; bg = g; }
                    }
                    const float pbest = xhalf(best); const int pbg = xhalf_i(bg);
                    const int myg = 2 * bg + hh, pg = 2 * pbg + (1 - hh);
                    own[mb] = (best > pbest) || (best == pbest && myg < pg);
                    float s4[4], b4[4];
#pragma unroll
                    for (int jj = 0; jj < 4; ++jj) {
                        s4[jj] = bg == 0 ? sc[jj] : bg == 1 ? sc[4 + jj] : bg == 2 ? sc[8 + jj] : sc[12 + jj];
                        b4[jj] = bg == 0 ? bs[jj] : bg == 1 ? bs[4 + jj] : bg == 2 ? bs[8 + jj] : bs[12 + jj];
                    }
                    int i0 = 0; float v0 = b4[0];
#pragma unroll
                    for (int jj = 1; jj < 4; ++jj) if (b4[jj] > v0) { v0 = b4[jj]; i0 = jj; }
                    int i1 = -1; float v1 = -1e30f;
#pragma unroll
                    for (int jj = 0; jj < 4; ++jj) if (jj != i0 && b4[jj] > v1) { v1 = b4[jj]; i1 = jj; }
                    const float sa = i0 == 0 ? s4[0] : i0 == 1 ? s4[1] : i0 == 2 ? s4[2] : s4[3];
                    const float sb = i1 == 0 ? s4[0] : i1 == 1 ? s4[1] : i1 == 2 ? s4[2] : s4[3];
                    const float inv = 1.0f / (sa + sb);
                    ga[mb] = sa * inv; gb[mb] = sb * inv;
                    e0[mb] = 4 * myg + i0; e1[mb] = 4 * myg + i1;
                    if (own[mb]) { ls0[mb] = (int)atomicAdd(&hist[e0[mb]], 1u); ls1[mb] = (int)atomicAdd(&hist[e1[mb]], 1u); }
                }
            }
            __syncthreads();
            if (threadIdx.x < 32) hist[32 + threadIdx.x] = atomicAdd(&cnt[64 * threadIdx.x], hist[threadIdx.x]);
            __syncthreads();
#pragma unroll
            for (int mb = 0; mb < 2; ++mb) {
                if (own[mb]) {
                    const int tok = m0 + wr * 64 + mb * 32 + r32;
                    const int s0 = (int)hist[32 + e0[mb]] + ls0[mb], s1 = (int)hist[32 + e1[mb]] + ls1[mb];
                    tes[tok * 2] = (e0[mb] << 24) | s0; tes[tok * 2 + 1] = (e1[mb] << 24) | s1;
                    tg[tok * 2] = ga[mb]; tg[tok * 2 + 1] = gb[mb];
                    list[(size_t)e0[mb] * NTOK + s0] = tok; list[(size_t)e1[mb] * NTOK + s1] = tok;
                }
            }
            __syncthreads();
        };
        gemm_tile<true, false>(arow, bt, D, epi);
    }
}

DI void moe_sched(const Params& p, int l) {
    const unsigned* cnt = (const unsigned*)(p.ws + WS_CTL) + CW_CNT + l * 2048;
    int* cnts = (int*)(smem + LDS_AUX + 1280); int* mts = (int*)(smem + LDS_AUX + 1536); int* rbs = (int*)(smem + LDS_AUX + 1792);
    __syncthreads();
    if (threadIdx.x < 32) cnts[threadIdx.x] = (int)cnt[64 * threadIdx.x];
    __syncthreads();
    if (threadIdx.x == 0) {
        int a = 0, b = 0;
        for (int e = 0; e < 32; ++e) { mts[e] = a; rbs[e] = b; a += (cnts[e] + 127) >> 7; b += cnts[e]; }
        mts[32] = a; rbs[32] = b;
    }
    __syncthreads();
}
DI int moe_find(const int* mts, int mtg) { int e = 0; for (int i = 1; i < 32; ++i) if (mts[i] <= mtg) e = i; return e; }

DI void phase_moe1(const Params& p, int l) {
    unsigned char* ws = p.ws;
    moe_sched(p, l);
    const int* cnts = (const int*)(smem + LDS_AUX + 1280); const int* mts = (const int*)(smem + LDS_AUX + 1536); const int* rbs = (const int*)(smem + LDS_AUX + 1792);
    if (blockIdx.x == 0 && threadIdx.x < 32) ((unsigned*)(ws + WS_CTL))[CW_BASE + l * 64 + threadIdx.x] = (unsigned)rbs[threadIdx.x];
    const bf16_t* hb = (const bf16_t*)(ws + WS_HBUF);
    const int* list = (const int*)(ws + WS_LIST);
    bf16_t* act = (bf16_t*)(ws + WS_ACT);
    const int total = mts[32] * 4;
    for (int u = blockIdx.x; u < total; u += gridDim.x) {
        const int mtg = u >> 2, nt = u & 3;
        const int e = moe_find(mts, mtg), mt = mtg - mts[e], ce = cnts[e], rb = rbs[e];
        const int* le = list + (size_t)e * NTOK;
        const bf16_t* bt = (const bf16_t*)(ws + WS_BTGU) + ((size_t)(l * NEXP + e) * 512 + nt * 128) * D;
        auto arow = [&](int r) { int s = mt * 128 + r; s = s < ce ? s : ce - 1; return hb + (size_t)le[s] * D; };
        auto epi = [&](const f32x16 (&acc)[2][2], int wr, int wc, int r32, int hh) {
#pragma unroll
            for (int mb = 0; mb < 2; ++mb) {
                const int s = mt * 128 + wr * 64 + mb * 32 + r32;
                if (s < ce) {
                    bf16_t* dst = act + (size_t)(rb + s) * DEXP + nt * 64 + wc * 32 + 4 * hh;
#pragma unroll
                    for (int g = 0; g < 4; ++g) {
                        float o[4];
#pragma unroll
                        for (int jj = 0; jj < 4; ++jj) { const float gv = acc[mb][0][4 * g + jj], uv = acc[mb][1][4 * g + jj]; o[jj] = gv * sigmoidf_(gv) * uv; }
                        st4bf(dst + 8 * g, o[0], o[1], o[2], o[3]);
                    }
                }
            }
        };
        gemm_tile<true, false>(arow, bt, D, epi);
    }
}

DI void phase_moe2(const Params& p, int l) {
    unsigned char* ws = p.ws;
    moe_sched(p, l);
    const int* cnts = (const int*)(smem + LDS_AUX + 1280); const int* mts = (const int*)(smem + LDS_AUX + 1536); const int* rbs = (const int*)(smem + LDS_AUX + 1792);
    const bf16_t* act = (const bf16_t*)(ws + WS_ACT);
    bf16_t* ys = (bf16_t*)(ws + WS_YS);
    const int total = mts[32] * 8;
    for (int u = blockIdx.x; u < total; u += gridDim.x) {
        const int mtg = u >> 3, nt = u & 7;
        const int e = moe_find(mts, mtg), mt = mtg - mts[e], ce = cnts[e], rb = rbs[e];
        const bf16_t* bt = (const bf16_t*)(ws + WS_BTD) + ((size_t)(l * NEXP + e) * D + nt * 128) * DEXP;
        auto arow = [&](int r) { int s = mt * 128 + r; s = s < ce ? s : ce - 1; return act + (size_t)(rb + s) * DEXP; };
        auto epi = [&](const f32x16 (&acc)[2][2], int wr, int wc, int r32, int hh) {
#pragma unroll
            for (int mb = 0; mb < 2; ++mb) {
                const int s = mt * 128 + wr * 64 + mb * 32 + r32;
                if (s < ce) {
                    bf16_t* dst = ys + (size_t)(rb + s) * D + nt * 128 + wc * 64 + 4 * hh;
#pragma unroll
                    for (int nb = 0; nb < 2; ++nb)
#pragma unroll
                        for (int g = 0; g < 4; ++g) st4bf(dst + nb * 32 + 8 * g, acc[mb][nb][4 * g], acc[mb][nb][4 * g + 1], acc[mb][nb][4 * g + 2], acc[mb][nb][4 * g + 3]);
                }
            }
        };
        gemm_tile<true, false>(arow, bt, DEXP, epi);
    }
}

template <int DQK, bool SBM>
DI void attn_unit(const bf16_t* __restrict__ Qb, const int qstr, const bf16_t* __restrict__ Kb, const int kstr, const bf16_t* __restrict__ VT, bf16_t* Ob, const int qt) {
    constexpr int KSTR = DQK * 2 + 16, KBUF = 64 * KSTR, VBUF = 64 * 144, OFF_V = 2 * KBUF;
    constexpr int CPR = DQK / 8, NKC = 64 * CPR / 256, NKS = DQK / 16;
    const int tid = otid(), lane = tid & 63, w = __builtin_amdgcn_readfirstlane(tid >> 6), r32 = lane & 31, hh = lane >> 5;
    const int q0 = qt * 128, qmin = q0 + 32 * w, myq = qmin + r32;
    const int NTL = 2 * qt + 2;
    bf16x8 qf[NKS];
#pragma unroll
    for (int ks = 0; ks < NKS; ++ks) qf[ks] = *(const bf16x8*)(Qb + (size_t)myq * qstr + ks * 16 + hh * 8);
    f32x16 o[2];
#pragma unroll
    for (int i = 0; i < 16; ++i) { o[0][i] = 0.f; o[1][i] = 0.f; }
    float mrun = -1e30f, lrun = 0.f, Lrun = 0.f;
    u32x4 rk[NKC], rv[2];
    auto gload = [&](int j) {
#pragma unroll
        for (int i = 0; i < NKC; ++i) { const int cid = tid + 256 * i, row = cid / CPR, c = cid % CPR; rk[i] = *(const u32x4*)(Kb + (size_t)(64 * j + row) * kstr + c * 8); }
#pragma unroll
        for (int i = 0; i < 2; ++i) { const int cid = tid + 256 * i, row = cid >> 3, c = cid & 7; rv[i] = *(const u32x4*)(VT + (size_t)row * SEQ + 64 * j + c * 8); }
    };
    auto lstore = [&](int buf) {
#pragma unroll
        for (int i = 0; i < NKC; ++i) { const int cid = tid + 256 * i, row = cid / CPR, c = cid % CPR; *(u32x4*)(smem + buf * KBUF + row * KSTR + c * 16) = rk[i]; }
#pragma unroll
        for (int i = 0; i < 2; ++i) { const int cid = tid + 256 * i, row = cid >> 3, c = cid & 7; *(u32x4*)(smem + OFF_V + buf * VBUF + row * 144 + c * 16) = rv[i]; }
    };
    unsigned* flags = (unsigned*)(smem + LDS_AUX + 512);
    gload(SBM ? NTL - 1 : 0); lstore(0); __syncthreads();
    for (int it = 0; it < NTL; ++it) {
        const int j = SBM ? NTL - 1 - it : it, buf = it & 1;
        const bool has_next = it + 1 < NTL;
        if (has_next) gload(SBM ? j - 1 : j + 1);
        const int kmin = 64 * j;
        const bool none = SBM ? (kmin >= qmin + 31) : (kmin > qmin + 31);
        if (!none) {
            const bool full = SBM ? (kmin + 63 < qmin) : (kmin + 63 <= qmin);
            f32x16 s[2];
#pragma unroll
            for (int kb = 0; kb < 2; ++kb) {
#pragma unroll
                for (int i = 0; i < 16; ++i) s[kb][i] = 0.f;
#pragma unroll
                for (int ks = 0; ks < NKS; ++ks) {
                    const bf16x8 kf = *(const bf16x8*)(smem + buf * KBUF + (32 * kb + r32) * KSTR + ks * 32 + hh * 16);
                    s[kb] = MFMA(kf, qf[ks], s[kb]);
                }
            }
            if (!SBM) {
                if (!full) {
#pragma unroll
                    for (int kb = 0; kb < 2; ++kb)
#pragma unroll
                        for (int i = 0; i < 16; ++i) if (kmin + 32 * kb + crow(i, hh) > myq) s[kb][i] = -INFINITY;
                }
                float mx = s[0][0];
#pragma unroll
                for (int kb = 0; kb < 2; ++kb)
#pragma unroll
                    for (int i = 0; i < 16; ++i) mx = fmaxf(mx, s[kb][i]);
                mx = fmaxf(mx, xhalf(mx));
                const float mnew = fmaxf(mrun, mx), al = fexp2(mrun - mnew);
                float rs = 0.f;
#pragma unroll
                for (int kb = 0; kb < 2; ++kb)
#pragma unroll
                    for (int i = 0; i < 16; ++i) { const float pz = fexp2(s[kb][i] - mnew); s[kb][i] = pz; rs += pz; }
                lrun = lrun * al + rs; mrun = mnew;
#pragma unroll
                for (int i = 0; i < 16; ++i) { o[0][i] *= al; o[1][i] *= al; }
            } else {
                f32x16 lk[2];
#pragma unroll
                for (int kb = 0; kb < 2; ++kb)
#pragma unroll
                    for (int i = 0; i < 16; ++i) {
                        const float z = s[kb][i];
                        float v = -(fmaxf(z, 0.f) + flog2(1.0f + fexp2(-fabsf(z))));
                        if (!full && !(kmin + 32 * kb + crow(i, hh) < myq)) v = 0.f;
                        lk[kb][i] = v;
                    }
                float run = Lrun;
#pragma unroll
                for (int kb = 1; kb >= 0; --kb)
#pragma unroll
                    for (int g = 3; g >= 0; --g) {
                        const float G = (lk[kb][4 * g] + lk[kb][4 * g + 1]) + (lk[kb][4 * g + 2] + lk[kb][4 * g + 3]);
                        const float Gp = xhalf(G);
                        float a = hh ? run : run + Gp;
#pragma unroll
                        for (int jl = 3; jl >= 0; --jl) {
                            const int i = 4 * g + jl;
                            const float l_ = lk[kb][i];
                            float wv = fexp2(s[kb][i] + l_ + a);
                            if (!full && !(kmin + 32 * kb + crow(i, hh) < myq)) wv = 0.f;
                            s[kb][i] = wv;
                            a += l_;
                        }
                        run += G + Gp;
                    }
                Lrun = run;
            }
#pragma unroll
            for (int kb = 0; kb < 2; ++kb)
#pragma unroll
                for (int sx = 0; sx < 2; ++sx) {
                    u32x4 pw;
                    pw.x = cvtpk(s[kb][8 * sx], s[kb][8 * sx + 1]); pw.y = cvtpk(s[kb][8 * sx + 2], s[kb][8 * sx + 3]);
                    pw.z = cvtpk(s[kb][8 * sx + 4], s[kb][8 * sx + 5]); pw.w = cvtpk(s[kb][8 * sx + 6], s[kb][8 * sx + 7]);
                    const bf16x8 pk = __builtin_bit_cast(bf16x8, pw);
#pragma unroll
                    for (int db = 0; db < 2; ++db) {
                        const bf16x8 vf = *(const bf16x8*)(smem + OFF_V + buf * VBUF + (32 * db + r32) * 144 + (32 * kb + 16 * sx + 8 * hh) * 2);
                        o[db] = MFMA(vf, pk, o[db]);
                    }
                }
        }
        if (has_next) lstore(buf ^ 1);
        if (SBM) { const bool alive = __any(Lrun > -160.0f); if (lane == 0) flags[(it & 1) * 4 + w] = alive ? 1u : 0u; }
        __syncthreads();
        if (SBM) { const unsigned f = flags[(it & 1) * 4] | flags[(it & 1) * 4 + 1] | flags[(it & 1) * 4 + 2] | flags[(it & 1) * 4 + 3]; if (f == 0u) break; }
    }
    float inv = 1.0f;
    if (!SBM) { const float lt = lrun + xhalf(lrun); inv = 1.0f / lt; }
#pragma unroll
    for (int db = 0; db < 2; ++db)
#pragma unroll
        for (int g = 0; g < 4; ++g)
            st4bf(Ob + (size_t)myq * D + 32 * db + 8 * g + 4 * hh, o[db][4 * g] * inv, o[db][4 * g + 1] * inv, o[db][4 * g + 2] * inv, o[db][4 * g + 3] * inv);
    __syncthreads();
}

DI void phase_attn(const Params& p, int l) {
    unsigned char* ws = p.ws;
    unsigned* head = (unsigned*)(ws + WS_CTL) + CW_ATTQ + 64 * l;
    const bf16_t* sbq = (const bf16_t*)(ws + WS_SBQ); const bf16_t* sbk = (const bf16_t*)(ws + WS_SBK); const bf16_t* sbvt = (const bf16_t*)(ws + WS_SBVT);
    const bf16_t* qm = (const bf16_t*)(ws + WS_QM); const bf16_t* km = (const bf16_t*)(ws + WS_KM); const bf16_t* mvt = (const bf16_t*)(ws + WS_MVT);
    bf16_t* mg = (bf16_t*)(ws + WS_HBUF);
    int* slot = (int*)(smem + LDS_AUX + 640);
    for (;;) {
        __syncthreads();
        if (threadIdx.x == 0) *slot = (int)__hip_atomic_fetch_add(head, 1u, __ATOMIC_RELAXED, __HIP_MEMORY_SCOPE_AGENT);
        __syncthreads();
        const int u = *slot;
        if (u >= 4096) break;
        const int v = u & 2047, qt = 15 - (v >> 7), bh = v & 127, b = bh >> 3, h = bh & 7;
        const size_t t0 = (size_t)b * SEQ;
        if (u < 2048) attn_unit<96, false>(qm + t0 * 768 + h * 96, 768, km + (t0 * 8 + h) * 96, 768, mvt + (size_t)bh * 64 * SEQ, mg + t0 * D + 512 + h * 64, qt);
        else attn_unit<64, true>(sbq + t0 * 512 + h * 64, 512, sbk + t0 * 512 + h * 64, 512, sbvt + (size_t)bh * 64 * SEQ, mg + t0 * D + h * 64, qt);
    }
}

__global__ void __launch_bounds__(256, 2) fwd_kernel(Params p) {
    if (threadIdx.x == 0) *(uint4*)(smem + LDS_BAR) = make_uint4(0u, 0u, 0u, 0u);
    __syncthreads();
    XcdBarrier bar = xcd_barrier_post((unsigned*)(p.ws + WS_CTL), (volatile LAS unsigned*)(smem + LDS_BAR));
    phase0(p);
    xcd_barrier(bar);
    phase_ln0(p);
    xcd_barrier(bar);
    for (int l = 0; l < DEPTH; ++l) {
        const float* xin = l == 0 ? p.x : p.out;
        phase_gemm1(p, l);   xcd_barrier(bar);
        phase_mlaprep(p, l); xcd_barrier(bar);
        phase_attn(p, l);    xcd_barrier(bar);
        phase_wo(p, l, xin); xcd_barrier(bar);
        phase_ln1(p, l);     xcd_barrier(bar);
        phase_router(p, l);  xcd_barrier(bar);
        phase_moe1(p, l);    xcd_barrier(bar);
        phase_moe2(p, l);    xcd_barrier(bar);
        phase_ln2(p, l, p.out);
        if (l + 1 < DEPTH) xcd_barrier(bar);
    }
}

extern "C" void kernel_launch(void* const* d_in, const int* in_sizes, int n_in, void* d_out, int out_size, void* d_ws, size_t ws_size, hipStream_t stream) {
    static int grid = 0;
    if (grid == 0) {
        if (n_in != 20 || out_size != NTOK * D || ws_size < WS_END) { fprintf(stderr, "kernel_launch: unexpected shapes (n_in %d, out %d, ws %zu, need %zu)\n", n_in, out_size, ws_size, (size_t)WS_END); grid = -1; return; }
        int dev = 0, cus = 0, per_cu = 0;
        if (hipGetDevice(&dev) != hipSuccess || hipDeviceGetAttribute(&cus, hipDeviceAttributeMultiprocessorCount, dev) != hipSuccess) { grid = -1; return; }
        if (hipFuncSetAttribute((const void*)fwd_kernel, hipFuncAttributeMaxDynamicSharedMemorySize, LDS_BYTES) != hipSuccess) { fprintf(stderr, "kernel_launch: hipFuncSetAttribute failed\n"); grid = -1; return; }
        if (hipOccupancyMaxActiveBlocksPerMultiprocessor(&per_cu, (const void*)fwd_kernel, 256, LDS_BYTES) != hipSuccess || per_cu < 1) { fprintf(stderr, "kernel_launch: occupancy query failed (%d)\n", per_cu); per_cu = 1; }
        (void)hipGetLastError();
        grid = cus * (per_cu < 2 ? per_cu : 2);
    }
    if (grid < 0) return;
    (void)hipMemsetAsync((char*)d_ws + WS_CTL, 0, CTL_BYTES, stream);
    Params p{};
    p.x = (const float*)d_in[0]; p.c = (const float*)d_in[1]; p.pos = (const int*)d_in[2];
    p.ada_w = (const float*)d_in[3]; p.ada_b = (const float*)d_in[4]; p.w_in = (const float*)d_in[5]; p.q_norm = (const float*)d_in[6]; p.kv_norm = (const float*)d_in[7];
    p.w_uq = (const float*)d_in[8]; p.w_ukv = (const float*)d_in[9]; p.w_o = (const float*)d_in[10]; p.ln1_g = (const float*)d_in[11]; p.ln1_b = (const float*)d_in[12];
    p.router_w = (const float*)d_in[13]; p.router_bias = (const float*)d_in[14]; p.w_gate = (const float*)d_in[15]; p.w_up = (const float*)d_in[16]; p.w_down = (const float*)d_in[17];
    p.ln2_g = (const float*)d_in[18]; p.ln2_b = (const float*)d_in[19];
    p.out = (float*)d_out; p.ws = (unsigned char*)d_ws;
    hipLaunchKernelGGL(fwd_kernel, dim3(grid), dim3(256), LDS_BYTES, stream, p);
}
```

```cpp
#include <hip/hip_runtime.h>
#include <cstdio>
#include <cstdint>

typedef unsigned short bf16_t;
typedef short bf16x8 __attribute__((ext_vector_type(8)));
typedef float f32x16 __attribute__((ext_vector_type(16)));
typedef float f32x4 __attribute__((ext_vector_type(4)));
typedef float f32x2 __attribute__((ext_vector_type(2)));
typedef unsigned u32x4 __attribute__((ext_vector_type(4)));
typedef unsigned u32x2 __attribute__((ext_vector_type(2)));
typedef __bf16 bf16x2_t __attribute__((ext_vector_type(2)));
#define DI __device__ __forceinline__
#define MFMA(a, b, c) __builtin_amdgcn_mfma_f32_32x32x16_bf16((a), (b), (c), 0, 0, 0)

constexpr int D = 1024, NB = 16, SEQ = 2048, NTOK = NB * SEQ, DEPTH = 2;
constexpr int INW = 1952, INWP = 2048;
constexpr int NEXP = 32, DEXP = 256;
constexpr int LATW = 416;
constexpr float ALPHA = 1.4142135623730951f;
constexpr float LOG2E = 1.4426950408889634f;

constexpr size_t MiB = 1024 * 1024;
constexpr size_t WS_CTL = 0;
constexpr size_t CTL_BYTES = 65536;
constexpr size_t WS_MOD = WS_CTL + CTL_BYTES;
constexpr size_t WS_CS = WS_MOD + (size_t)DEPTH * NB * 6144 * 4;
constexpr size_t WS_BTIN = WS_CS + (size_t)NTOK * 32 * 4;
constexpr size_t WS_BTUQ = WS_BTIN + (size_t)DEPTH * INWP * D * 2;
constexpr size_t WS_BTUKV = WS_BTUQ + (size_t)DEPTH * 768 * 256 * 2;
constexpr size_t WS_BTO = WS_BTUKV + (size_t)DEPTH * 1024 * 128 * 2;
constexpr size_t WS_BTGU = WS_BTO + (size_t)DEPTH * D * D * 2;
constexpr size_t WS_BTD = WS_BTGU + (size_t)DEPTH * NEXP * 512 * D * 2;
constexpr size_t WS_BTR = WS_BTD + (size_t)DEPTH * NEXP * D * DEXP * 2;
constexpr size_t WS_RSTD = WS_BTR + (size_t)256 * D * 2;
constexpr size_t WS_TOKES = WS_RSTD + (size_t)2 * NTOK * 4;
constexpr size_t WS_TOKG = WS_TOKES + (size_t)NTOK * 2 * 4;
constexpr size_t WS_LIST = WS_TOKG + (size_t)NTOK * 2 * 4;
constexpr size_t WS_HBUF = WS_LIST + (size_t)NEXP * NTOK * 4;
constexpr size_t WS_REG = WS_HBUF + (size_t)NTOK * D * 2;
constexpr size_t WS_SBQ = WS_REG;
constexpr size_t WS_SBK = WS_SBQ + (size_t)NTOK * 512 * 2;
constexpr size_t WS_SBV = WS_SBK + (size_t)NTOK * 512 * 2;
constexpr size_t WS_LAT = WS_SBV + (size_t)NTOK * 512 * 2;
constexpr size_t WS_QM = WS_LAT + (size_t)NTOK * LATW * 2;
constexpr size_t WS_KM = WS_QM + (size_t)NTOK * 768 * 2;
constexpr int KVREC = 128;
constexpr size_t WS_ATT_END = WS_KM + (size_t)NTOK * 8 * KVREC * 2;
constexpr size_t WS_X1 = WS_REG;
constexpr size_t WS_YS = WS_X1 + (size_t)NTOK * D * 4;
constexpr size_t WS_ACT = WS_YS + (size_t)2 * NTOK * D * 2;
constexpr size_t WS_MIX = WS_YS;
constexpr size_t WS_FFN_END = WS_ACT + (size_t)2 * NTOK * DEXP * 2;
constexpr size_t WS_XB = WS_ACT;
static_assert(WS_ACT >= WS_ATT_END, "XB must lie behind the attention-time view");
constexpr size_t WS_XB_END = WS_XB + (size_t)NTOK * D * 2;
constexpr size_t WS_END0 = WS_ATT_END > WS_FFN_END ? WS_ATT_END : WS_FFN_END;
constexpr size_t WS_END = WS_END0 > WS_XB_END ? WS_END0 : WS_XB_END;

constexpr int CW_ATTQ = 4096;
constexpr int CW_CONVQ = 4096 + 64 * 3 + 32;
constexpr int CW_CNT = 4352;
constexpr int CW_BASE = 8448;

constexpr int TILE_B = 256 * 64 * 2;
constexpr int STAGE_B = 2 * TILE_B;
constexpr int LDS_AUX = 150 * 1024;
constexpr int AUX_ROWSS = 0, AUX_FLAGS = 1024, AUX_SLOT = 1088, AUX_HIST = 1152, AUX_CNTS = 1536, AUX_MTS = 1792, AUX_RBS = 2048;
constexpr int LDS_BAR = LDS_AUX + 4096;
constexpr int LDS_BYTES = LDS_BAR + 16;
constexpr int NTHR = 512, NWAVE = 8;
extern __shared__ __attribute__((aligned(1024))) char smem[];

#define XB_TMO      128
#define XB_XCNT(j)  (256  + 64 * (j))
#define XB_XSUB(j)  (1280 + 64 * (j))
#define XB_XGEN(j)  (2304 + 64 * (j))
#define XB_TOP      3328
#define XB_TOPGEN   3392
#define XCD_BAR_WORDS 3456
#define XB_SPIN_CAP (1u << 20)
#define LAS __attribute__((address_space(3)))
DI unsigned xb_ld(unsigned* p)              { return __hip_atomic_load(p, __ATOMIC_RELAXED, __HIP_MEMORY_SCOPE_AGENT); }
DI unsigned xb_add(unsigned* p, unsigned v) { return __hip_atomic_fetch_add(p, v, __ATOMIC_RELAXED, __HIP_MEMORY_SCOPE_AGENT); }
DI unsigned xb_xcc_id() { return (unsigned)__builtin_amdgcn_s_getreg((3 << 11) | 20) & 0xFu; }
#define XB_SPIN(cond, bar) do { unsigned _sp = 0; while (cond) { __builtin_amdgcn_s_sleep(1); \
    if ((++_sp & 255u) == 0u) { if (xb_ld(&(bar)[XB_TMO])) break; if (_sp > XB_SPIN_CAP) { atomicAdd(&(bar)[XB_TMO], 1u); break; } } } } while (0)
struct XcdBarrier { unsigned* bar; unsigned x; volatile LAS unsigned* st; };
DI XcdBarrier xcd_barrier_post(unsigned* bar, volatile LAS unsigned* st) {
    XcdBarrier b; b.bar = bar; b.x = xb_xcc_id(); b.st = st;
    if (threadIdx.x == 0) (void)xb_add(&bar[XB_XCNT(b.x)], 1u);
    return b;
}
DI void xcd_barrier_complete(unsigned* bar, unsigned x, unsigned& nloc, unsigned& nx) {
    const unsigned G = gridDim.x * gridDim.y * gridDim.z;
    unsigned sum, cnt, mine, sp = 0u;
    for (;;) {
        sum = 0u; cnt = 0u; mine = 0u;
#pragma unroll
        for (unsigned j = 0; j < 16; ++j) { const unsigned c = xb_ld(&bar[XB_XCNT(j)]); sum += c; cnt += (c > 0u) ? 1u : 0u; mine = (j == x) ? c : mine; }
        if (sum == G) break;
        __builtin_amdgcn_s_sleep(1);
        if ((++sp & 255u) == 0u) { if (xb_ld(&bar[XB_TMO])) break; if (sp > XB_SPIN_CAP) { atomicAdd(&bar[XB_TMO], 1u); break; } }
    }
    nloc = mine > 0u ? mine : 1u; nx = cnt > 0u ? cnt : 1u;
}
DI void xcd_barrier(const XcdBarrier& b_) {
    XcdBarrier b; b.bar = b_.bar; b.x = xb_xcc_id(); b.st = (volatile LAS unsigned*)(smem + LDS_BAR);
    asm volatile("s_waitcnt vmcnt(0)" ::: "memory");
    __syncthreads();
    if (threadIdx.x == 0) {
        unsigned* bar = b.bar;
        __builtin_amdgcn_s_waitcnt(0);
        unsigned nloc = b.st[0], nx = b.st[1];
        if (nloc == 0u) { xcd_barrier_complete(bar, b.x, nloc, nx); b.st[0] = nloc; b.st[1] = nx; }
        const unsigned old = xb_add(&bar[XB_XSUB(b.x)], 1u);
        const unsigned gen = old / nloc;
        if (old + 1u == (gen + 1u) * nloc) {
            __builtin_amdgcn_fence(__ATOMIC_RELEASE, "agent");
            asm volatile("s_waitcnt vmcnt(0)" ::: "memory");
            const unsigned og = xb_add(&bar[XB_TOP], 1u);
            const unsigned tg = og / nx;
            if (og + 1u == (tg + 1u) * nx) xb_add(&bar[XB_TOPGEN], 1u);
            else XB_SPIN(xb_ld(&bar[XB_TOPGEN]) == tg, bar);
            __builtin_amdgcn_fence(__ATOMIC_ACQUIRE, "agent");
            xb_add(&bar[XB_XGEN(b.x)], 1u);
            asm volatile("s_waitcnt vmcnt(0)" ::: "memory");
        } else {
            XB_SPIN(xb_ld(&bar[XB_XGEN(b.x)]) == gen, bar);
            __builtin_amdgcn_fence(__ATOMIC_ACQUIRE, "agent");
            asm volatile("s_waitcnt vmcnt(0)" ::: "memory");
        }
    }
    __syncthreads();
}

DI float bf2f(unsigned v16) { return __uint_as_float(v16 << 16); }
DI unsigned cvtpk(float lo, float hi) { f32x2 v = {lo, hi}; bf16x2_t b = __builtin_convertvector(v, bf16x2_t); return __builtin_bit_cast(unsigned, b); }
DI int crow(int i, int h) { return (i & 3) + 8 * (i >> 2) + 4 * h; }
DI float dpp_add(float v, const int ctrl_tag) {
    int r;
    if (ctrl_tag == 0) r = __builtin_amdgcn_update_dpp(0, __float_as_int(v), 0xB1, 0xf, 0xf, true);
    else if (ctrl_tag == 1) r = __builtin_amdgcn_update_dpp(0, __float_as_int(v), 0x4E, 0xf, 0xf, true);
    else if (ctrl_tag == 2) r = __builtin_amdgcn_update_dpp(0, __float_as_int(v), 0x124, 0xf, 0xf, true);
    else r = __builtin_amdgcn_update_dpp(0, __float_as_int(v), 0x128, 0xf, 0xf, true);
    return v + __int_as_float(r);
}
DI float wsum(float v) {
    v = dpp_add(v, 0); v = dpp_add(v, 1); v = dpp_add(v, 2); v = dpp_add(v, 3);
    const int iv = __float_as_int(v);
    return (__int_as_float(__builtin_amdgcn_readlane(iv, 0)) + __int_as_float(__builtin_amdgcn_readlane(iv, 16))) +
           (__int_as_float(__builtin_amdgcn_readlane(iv, 32)) + __int_as_float(__builtin_amdgcn_readlane(iv, 48)));
}
DI float xhalf(float v) {
    const unsigned mine = __float_as_uint(v);
    auto rr = __builtin_amdgcn_permlane32_swap(mine, mine, false, false);
    const unsigned a = rr[0], b = rr[1];
    return __uint_as_float(a == mine ? b : a);
}
DI int xhalf_i(int v) {
    const unsigned mine = (unsigned)v;
    auto rr = __builtin_amdgcn_permlane32_swap(mine, mine, false, false);
    const unsigned a = rr[0], b = rr[1];
    return (int)(a == mine ? b : a);
}
DI int otid() { int t = threadIdx.x; asm volatile("" : "+v"(t)); return t; }
DI void st4bf(bf16_t* pz, float a, float b, float c, float d);
DI void st4bf(bf16_t* pz, const f32x4& v);
DI float fexp2(float x) { return __builtin_amdgcn_exp2f(x); }
DI float flog2(float x) { return __builtin_amdgcn_logf(x); }
DI float frcp(float x) { return __builtin_amdgcn_rcpf(x); }
DI float sigmoidf_(float x) { return frcp(1.0f + fexp2(-x * LOG2E)); }

struct Params {
    const float *x, *c; const int* pos;
    const float *ada_w, *ada_b, *w_in, *q_norm, *kv_norm, *w_uq, *w_ukv, *w_o, *ln1_g, *ln1_b, *router_w, *router_bias, *w_gate, *w_up, *w_down, *ln2_g, *ln2_b;
    float* out; unsigned char* ws;
};


DI int lds_byte(int r, int c) { const int st = (r >> 4) * 2 + (c >> 5), ob = (r & 15) * 64 + (c & 31) * 2; return st * 1024 + (ob ^ (((ob >> 9) & 1) << 5)); }
DI void stage_rc(int b, int& R, int& C) { const int st = b >> 10, sb = b & 1023, swz = sb ^ (((sb >> 9) & 1) << 5); R = (st >> 1) * 16 + swz / 64; C = (st & 1) * 32 + (swz % 64) / 2; }
#define MFMA16(a, b, c) __builtin_amdgcn_mfma_f32_16x16x32_bf16((a), (b), (c), 0, 0, 0)

template <class U, class Get, class ARow, class BRow, class KF, class KO, class Epi>
DI void gemm_stream(const char* abase, const char* bbase, const Get& get, const ARow& arow, const BRow& brow, const KF& kf, const KO& ko, const Epi& epi) {
    const int tid = otid(), lane = tid & 63, wid = __builtin_amdgcn_readfirstlane(tid >> 6), wr = wid >> 2, wc = wid & 3, fr = lane & 15, fq = lane >> 4;
    U cur, nxt;
    int r = 0;
    if (!get(0, cur)) return;
    unsigned ao[4], bo[4];
    auto setptr = [&](const U& u) {
        const int t2 = otid();
#pragma unroll
        for (int i = 0; i < 4; ++i) { int R, C; stage_rc((t2 >> 6) * 1024 + i * 8192 + (t2 & 63) * 16, R, C); ao[i] = arow(u, R) + 2 * C; bo[i] = brow(u, R) + 2 * C; }
    };
    setptr(cur);
#define GLDS_STAGE(buf, kt) do { _Pragma("unroll") for (int i = 0; i < 4; ++i) { \
        __builtin_amdgcn_global_load_lds((const unsigned*)(abase + ao[i] + (kt) * 128), (unsigned*)(smem + (buf) * STAGE_B + wid * 1024 + i * 8192), 16, 0, 0); \
        __builtin_amdgcn_global_load_lds((const unsigned*)(bbase + bo[i] + (kt) * 128), (unsigned*)(smem + (buf) * STAGE_B + TILE_B + wid * 1024 + i * 8192), 16, 0, 0); } } while (0)
    int bufi = 0;
    GLDS_STAGE(0, ko(cur) & ((kf(cur) >> 6) - 1));
    asm volatile("s_waitcnt vmcnt(0)" ::: "memory"); __syncthreads();
    for (;;) {
        const int KT = kf(cur) >> 6, k0 = ko(cur);
        const bool has_next = get(r + 1, nxt);
        f32x4 acc[8][4];
#pragma unroll
        for (int m = 0; m < 8; ++m)
#pragma unroll
            for (int n = 0; n < 4; ++n) acc[m][n] = (f32x4){0.f, 0.f, 0.f, 0.f};
#pragma unroll 1
        for (int t = 0; t < KT; ++t) {
            if (t + 1 < KT) GLDS_STAGE(bufi ^ 1, (t + 1 + k0) & (KT - 1));
            else if (has_next) { setptr(nxt); GLDS_STAGE(bufi ^ 1, ko(nxt) & ((kf(nxt) >> 6) - 1)); }
            const char* sa = smem + bufi * STAGE_B; const char* sb = sa + TILE_B;
            __builtin_amdgcn_sched_barrier(0);
            {
                bf16x8 At[2][8], Bf[2][4];
#pragma unroll
                for (int ks = 0; ks < 2; ++ks) {
#pragma unroll
                    for (int n = 0; n < 4; ++n) Bf[ks][n] = *(const bf16x8*)(sb + lds_byte(wc * 64 + n * 16 + fr, ks * 32 + fq * 8));
#pragma unroll
                    for (int m = 0; m < 8; ++m) At[ks][m] = *(const bf16x8*)(sa + lds_byte(wr * 128 + m * 16 + fr, ks * 32 + fq * 8));
                }
#pragma unroll
                for (int ks = 0; ks < 2; ++ks)
#pragma unroll
                    for (int m = 0; m < 8; ++m)
#pragma unroll
                        for (int n = 0; n < 4; ++n) acc[m][n] = MFMA16(Bf[ks][n], At[ks][m], acc[m][n]);
                __builtin_amdgcn_sched_group_barrier(0x100, 12, 0);
#pragma unroll
                for (int g = 0; g < 16; ++g) {
                    __builtin_amdgcn_sched_group_barrier(0x008, 4, 0);
                    if (g < 4) __builtin_amdgcn_sched_group_barrier(0x100, 2, 0);
                    else if (g < 8) __builtin_amdgcn_sched_group_barrier(0x100, 1, 0);
                }
            }
            __builtin_amdgcn_sched_barrier(0);
            asm volatile("s_waitcnt vmcnt(0)" ::: "memory"); __syncthreads();
            bufi ^= 1;
        }
        epi(cur, acc, wr, wc, fr, fq, smem + (bufi ^ 1) * STAGE_B);
        if (!has_next) break;
        cur = nxt; ++r;
    }
#undef GLDS_STAGE
    __syncthreads();
}

struct ConvJob { const float* src; const float* src2; const float* kscale; bf16_t* dst; int N, K, nvalid, mode, k0, n0p; };
constexpr int CV_PITCH = 516;
DI void conv_load(const ConvJob& J, int tid, f32x4 (&v)[8]) {
    const int kk = tid >> 3, np = J.n0p + (tid & 7) * 32;
    const float* s = J.src; int col;
    if (J.mode == 0) col = np < J.nvalid ? np : -1;
    else if (J.mode == 1) col = np < 512 ? ((np >> 6) * 128 + (np & 63)) : (((np - 512) >> 6) * 128 + 64 + (np & 63));
    else { col = (np >> 8) * 128 + ((np >> 6) & 3) * 32; s = ((np >> 5) & 1) ? J.src2 : J.src; }
    const float* rowp = s + (size_t)(J.k0 + kk) * J.N + col;
#pragma unroll
    for (int i = 0; i < 8; ++i) v[i] = (col >= 0) ? *(const f32x4*)(rowp + 4 * i) : (f32x4){0.f, 0.f, 0.f, 0.f};
}
DI void conv_store(const ConvJob& J, int tid, const f32x4 (&v)[8]) {
    const int kk = tid >> 3, ch = tid & 7;
    const float ks = J.kscale ? J.kscale[J.k0 + kk] : 1.0f;
    __syncthreads();
#pragma unroll
    for (int i = 0; i < 8; ++i) {
        *(unsigned*)(smem + kk * CV_PITCH + ch * 64 + i * 8) = cvtpk(v[i][0] * ks, v[i][1] * ks);
        *(unsigned*)(smem + kk * CV_PITCH + ch * 64 + i * 8 + 4) = cvtpk(v[i][2] * ks, v[i][3] * ks);
    }
    __syncthreads();
#pragma unroll
    for (int i = 0; i < 4; ++i) {
        const int c = tid + NTHR * i, n = c >> 3, kc = c & 7;
        unsigned short e[8];
#pragma unroll
        for (int q = 0; q < 8; ++q) e[q] = *(const unsigned short*)(smem + (kc * 8 + q) * CV_PITCH + n * 2);
        u32x4 w;
        w.x = e[0] | ((unsigned)e[1] << 16); w.y = e[2] | ((unsigned)e[3] << 16); w.z = e[4] | ((unsigned)e[5] << 16); w.w = e[6] | ((unsigned)e[7] << 16);
        *(u32x4*)(J.dst + (size_t)(J.n0p + n) * J.K + J.k0 + kc * 8) = w;
    }
}

constexpr int CT_IN = 16 * 8, CT_UQ = 4 * 3, CT_UKV = 2 * 4, CT_O = 16 * 4, CT_GU = 32 * 16 * 2, CT_D = 32 * 4 * 4, CT_R = 16;
constexpr int CC1 = CT_IN, CC2 = CC1 + CT_UQ, CC3 = CC2 + CT_UKV, CC4 = CC3 + CT_O, CC5 = CC4 + CT_GU, CC6 = CC5 + CT_D;
DI ConvJob conv_job(const Params& p, int l, int t) {
    unsigned char* ws = p.ws;
    ConvJob J;
    if (t < CC1) { const int r = t; J = {p.w_in + (size_t)l * D * INW, nullptr, nullptr, (bf16_t*)(ws + WS_BTIN) + (size_t)l * INWP * D, INW, D, INW, 0, (r & 15) * 64, (r >> 4) * 256}; }
    else if (t < CC2) { const int r = t - CC1; J = {p.w_uq + (size_t)l * 256 * 768, nullptr, p.q_norm + l * 256, (bf16_t*)(ws + WS_BTUQ) + (size_t)l * 768 * 256, 768, 256, 768, 0, (r & 3) * 64, (r >> 2) * 256}; }
    else if (t < CC3) { const int r = t - CC2; J = {p.w_ukv + (size_t)l * 128 * 1024, nullptr, p.kv_norm + l * 128, (bf16_t*)(ws + WS_BTUKV) + (size_t)l * 1024 * 128, 1024, 128, 1024, 0, (r & 1) * 64, (r >> 1) * 256}; }
    else if (t < CC4) { const int r = t - CC3; J = {p.w_o + (size_t)l * D * D, nullptr, nullptr, (bf16_t*)(ws + WS_BTO) + (size_t)l * D * D, D, D, D, 0, (r & 15) * 64, (r >> 4) * 256}; }
    else if (t < CC5) { const int u = t - CC4, le = l * NEXP + u / 32, r = u % 32; J = {p.w_gate + (size_t)le * D * DEXP, p.w_up + (size_t)le * D * DEXP, nullptr, (bf16_t*)(ws + WS_BTGU) + (size_t)le * 512 * D, DEXP, D, 512, 2, (r & 15) * 64, (r >> 4) * 256}; }
    else if (t < CC6) { const int u = t - CC5, le = l * NEXP + u / 16, r = u % 16; J = {p.w_down + (size_t)le * DEXP * D, nullptr, nullptr, (bf16_t*)(ws + WS_BTD) + (size_t)le * D * DEXP, D, DEXP, D, 0, (r & 3) * 64, (r >> 2) * 256}; }
    else { const int r = t - CC6; J = {p.router_w, nullptr, nullptr, (bf16_t*)(ws + WS_BTR), NEXP, D, NEXP, 0, r * 64, 0}; }
    return J;
}
DI void conv_run(const Params& p, int l, bool with_router, int first, int stride) {
    const int tid = otid();
    const int n = CC6 + (with_router ? CT_R : 0);
    __syncthreads();
    int it = first;
    if (it < n) {
        f32x4 cur[8], nxt[8];
        ConvJob J = conv_job(p, l, it);
        conv_load(J, tid, cur);
        for (;;) {
            const int itn = it + stride;
            ConvJob Jn = J;
            if (itn < n) { Jn = conv_job(p, l, itn); conv_load(Jn, tid, nxt); }
            conv_store(J, tid, cur);
            if (itn >= n) break;
#pragma unroll
            for (int i = 0; i < 8; ++i) cur[i] = nxt[i];
            J = Jn; it = itn;
        }
    }
    __syncthreads();
}

DI void conv_run_queue(const Params& p, int l, bool with_router, unsigned* head) {
    const int tid = otid();
    const int n = CC6 + (with_router ? CT_R : 0);
    int* slot = (int*)(smem + LDS_AUX + AUX_SLOT);
    auto fetch = [&]() { int v = 0; if (otid() == 0) v = (int)__hip_atomic_fetch_add(head, 1u, __ATOMIC_RELAXED, __HIP_MEMORY_SCOPE_AGENT); return v; };
    auto share = [&](int v) { __syncthreads(); if (otid() == 0) *slot = v; __syncthreads(); return *slot; };
    int it = share(fetch());
    if (it < n) {
        f32x4 cur[8], nxt[8];
        ConvJob J = conv_job(p, l, it);
        conv_load(J, tid, cur);
        for (;;) {
            const int itn = share(fetch());
            ConvJob Jn = J;
            if (itn < n) { Jn = conv_job(p, l, itn); conv_load(Jn, tid, nxt); }
            conv_store(J, tid, cur);
            if (itn >= n) break;
#pragma unroll
            for (int i = 0; i < 8; ++i) cur[i] = nxt[i];
            J = Jn; it = itn;
        }
    }
    __syncthreads();
}

DI void phase0(const Params& p) {
    unsigned char* ws = p.ws;
    const int tid = otid();
    constexpr int N_MOD = 2 * 96, N_CS = NTOK / NTHR;
    for (int it = blockIdx.x; it < N_MOD + N_CS; it += gridDim.x) {
        if (it < N_MOD) {
            const int l = it / 96, n0 = (it % 96) * 64;
            float* sc = (float*)smem;
            __syncthreads();
            for (int i = tid; i < NB * D; i += NTHR) { const float v = p.c[i]; sc[i] = v * sigmoidf_(v); }
            __syncthreads();
            const int n = tid & 63, kq = tid >> 6;
            float acc[16];
#pragma unroll
            for (int b = 0; b < 16; ++b) acc[b] = 0.f;
            const float* wp = p.ada_w + (size_t)l * D * 6144 + n0 + n;
#pragma unroll 2
            for (int k = kq * 128; k < kq * 128 + 128; k += 4) {
                const float w0 = wp[(size_t)k * 6144], w1 = wp[(size_t)(k + 1) * 6144], w2 = wp[(size_t)(k + 2) * 6144], w3 = wp[(size_t)(k + 3) * 6144];
#pragma unroll
                for (int b = 0; b < 16; ++b) { const f32x4 s4 = *(const f32x4*)(sc + b * D + k); acc[b] += (s4[0] * w0 + s4[1] * w1) + (s4[2] * w2 + s4[3] * w3); }
            }
            float* part = (float*)(smem + 65536);
#pragma unroll
            for (int b = 0; b < 16; ++b) part[(kq * 16 + b) * 64 + n] = acc[b];
            __syncthreads();
            for (int i = tid; i < 16 * 64; i += NTHR) {
                const int b = i >> 6, nn = i & 63;
                float v = 0.f;
#pragma unroll
                for (int q = 0; q < 8; ++q) v += part[(q * 16 + b) * 64 + nn];
                ((float*)(ws + WS_MOD))[((size_t)l * NB + b) * 6144 + n0 + nn] = v + p.ada_b[(size_t)l * 6144 + n0 + nn];
            }
        } else {
            const int t = (it - N_MOD) * NTHR + tid;
            const float posf = (float)p.pos[t];
            float* cs = (float*)(ws + WS_CS) + (size_t)t * 32;
#pragma unroll
            for (int i = 0; i < 16; ++i) {
                const float inv = (float)exp2(-(double)i * (13.287712379549449 / 16.0));
                const float ang = posf * inv;
                const double rev = (double)ang * 0.15915494309189535;
                const float fr = (float)(rev - rint(rev));
                cs[i] = __builtin_amdgcn_cosf(fr);
                cs[16 + i] = __builtin_amdgcn_sinf(fr);
            }
        }
    }
    conv_run_queue(p, 0, true, (unsigned*)(ws + WS_CTL) + CW_CONVQ);
}

constexpr int RPW = NTOK / (256 * NWAVE);
struct RowVec { f32x4 v[4]; };
struct RowRaw { u32x4 w[2]; };
DI f32x4 bf4(unsigned a, unsigned b) { return (f32x4){bf2f(a & 0xffffu), bf2f(a >> 16), bf2f(b & 0xffffu), bf2f(b >> 16)}; }
DI void ldvec(RowVec& r, const float* base, int lane) {
#pragma unroll
    for (int i = 0; i < 2; ++i) { r.v[2 * i] = *(const f32x4*)(base + 512 * i + 8 * lane); r.v[2 * i + 1] = *(const f32x4*)(base + 512 * i + 8 * lane + 4); }
}
DI void ldraw(RowRaw& r, const bf16_t* base, int lane) {
#pragma unroll
    for (int i = 0; i < 2; ++i) r.w[i] = *(const u32x4*)(base + 512 * i + 8 * lane);
}
DI void raw2vec(RowVec& r, const RowRaw& q) {
#pragma unroll
    for (int i = 0; i < 2; ++i) { r.v[2 * i] = bf4(q.w[i].x, q.w[i].y); r.v[2 * i + 1] = bf4(q.w[i].z, q.w[i].w); }
}
DI void stvec_bf(bf16_t* base, const f32x4 (&v)[4], int lane) {
#pragma unroll
    for (int i = 0; i < 2; ++i) {
        u32x4 w; w.x = cvtpk(v[2 * i][0], v[2 * i][1]); w.y = cvtpk(v[2 * i][2], v[2 * i][3]); w.z = cvtpk(v[2 * i + 1][0], v[2 * i + 1][1]); w.w = cvtpk(v[2 * i + 1][2], v[2 * i + 1][3]);
        *(u32x4*)(base + 512 * i + 8 * lane) = w;
    }
}
DI void stvec_f32(float* base, const f32x4 (&v)[4], int lane) {
#pragma unroll
    for (int i = 0; i < 2; ++i) { *(f32x4*)(base + 512 * i + 8 * lane) = v[2 * i]; *(f32x4*)(base + 512 * i + 8 * lane + 4) = v[2 * i + 1]; }
}
DI void row_stats2(const f32x4 (&a)[4], const f32x4 (&b)[4], float& mua, float& rsa, float& mub, float& rsb) {
    float sa = 0.f, sb = 0.f;
#pragma unroll
    for (int i = 0; i < 4; ++i) { sa += (a[i][0] + a[i][1]) + (a[i][2] + a[i][3]); sb += (b[i][0] + b[i][1]) + (b[i][2] + b[i][3]); }
    mua = wsum(sa) * (1.0f / D); mub = wsum(sb) * (1.0f / D);
    float qa = 0.f, qb = 0.f;
#pragma unroll
    for (int i = 0; i < 4; ++i)
#pragma unroll
        for (int j = 0; j < 4; ++j) { const float da = a[i][j] - mua, db = b[i][j] - mub; qa += da * da; qb += db * db; }
    rsa = __builtin_amdgcn_rsqf(wsum(qa) * (1.0f / D) + 1e-5f); rsb = __builtin_amdgcn_rsqf(wsum(qb) * (1.0f / D) + 1e-5f);
}
DI void lds_vec_fill(int slot, const float* src, int tid) { for (int i = tid; i < D / 4; i += NTHR) *(f32x4*)(smem + 4096 * slot + 16 * i) = *(const f32x4*)(src + 4 * i); }
DI f32x4 lv(int slot, int i, int lane) { return *(const f32x4*)(smem + 4096 * slot + (512 * (i >> 1) + 8 * lane + 4 * (i & 1)) * 4); }
DI void modulate_store2(const f32x4 (&a)[4], const f32x4 (&b)[4], int sl_shift, int sl_scale, bf16_t* ha, bf16_t* hb_, int lane) {
    float mua, rsa, mub, rsb; row_stats2(a, b, mua, rsa, mub, rsb);
    f32x4 oa[4], ob[4];
#pragma unroll
    for (int i = 0; i < 4; ++i) { const f32x4 sc = lv(sl_scale, i, lane) + 1.0f, sh = lv(sl_shift, i, lane); oa[i] = (a[i] - mua) * rsa * sc + sh; ob[i] = (b[i] - mub) * rsb * sc + sh; }
    stvec_bf(ha, oa, lane); stvec_bf(hb_, ob, lane);
}
DI void affine_lds(f32x4 (&v)[4], float mu, float rs, int sl_g, int sl_b, int lane) {
#pragma unroll
    for (int i = 0; i < 4; ++i) v[i] = (v[i] - mu) * rs * lv(sl_g, i, lane) + lv(sl_b, i, lane);
}
constexpr int LNROWS = NWAVE * RPW;

DI void phase_ln0(const Params& p) {
    const int tid_ = otid(), lane = tid_ & 63, wv = tid_ >> 6;
    const float* mod = (const float*)(p.ws + WS_MOD);
    bf16_t* hb = (bf16_t*)(p.ws + WS_HBUF);
    for (int rb = blockIdx.x * LNROWS; rb < NTOK; rb += gridDim.x * LNROWS) {
        const int b = rb / SEQ, r0 = rb + wv * RPW;
        __syncthreads();
        lds_vec_fill(0, mod + (size_t)b * 6144, tid_); lds_vec_fill(1, mod + (size_t)b * 6144 + 1024, tid_);
        __syncthreads();
        RowVec c0, c1;
        ldvec(c0, p.x + (size_t)r0 * D, lane); ldvec(c1, p.x + (size_t)(r0 + 1) * D, lane);
#pragma unroll 1
        for (int k = 0; k < RPW; k += 2) {
            const int row = r0 + k;
            f32x4 va[4], vb[4];
#pragma unroll
            for (int i = 0; i < 4; ++i) { va[i] = c0.v[i]; vb[i] = c1.v[i]; }
            if (k + 2 < RPW) { ldvec(c0, p.x + (size_t)(row + 2) * D, lane); ldvec(c1, p.x + (size_t)(row + 3) * D, lane); }
            modulate_store2(va, vb, 0, 1, hb + (size_t)row * D, hb + (size_t)(row + 1) * D, lane);
        }
    }
}

constexpr int RT_W = 20480, RT_PITCH = 2064, RT_STG = RT_W + 32 * RT_PITCH + 16;
static_assert(RT_STG + NWAVE * 4 * RT_PITCH <= LDS_AUX, "router staging must end below the aux region");
template <bool XBF>
DI void phase_ln1(const Params& p, int l) {
    const int tid_ = otid(), lane = tid_ & 63, wv = tid_ >> 6, fr = lane & 15, fq = lane >> 4;
    const float* mod = (const float*)(p.ws + WS_MOD) + (size_t)l * NB * 6144;
    bf16_t* x1 = (bf16_t*)(p.ws + WS_X1);
    const bf16_t* mix = (const bf16_t*)(p.ws + WS_MIX);
    const bf16_t* xb = (const bf16_t*)(p.ws + WS_XB);
    bf16_t* hb = (bf16_t*)(p.ws + WS_HBUF);
    const bf16_t* btr = (const bf16_t*)(p.ws + WS_BTR);
    const float* rbias = p.router_bias;
    unsigned* cnt = (unsigned*)(p.ws + WS_CTL) + CW_CNT + l * 2048;
    int* tes = (int*)(p.ws + WS_TOKES); float* tg = (float*)(p.ws + WS_TOKG); int* list = (int*)(p.ws + WS_LIST);
    unsigned* hist = (unsigned*)(smem + LDS_AUX + AUX_HIST);
    char* stg = smem + RT_STG + wv * (4 * RT_PITCH);
    struct In { RowVec x; RowRaw xr; RowRaw m; };
    __syncthreads();
    for (int i = tid_; i < 32 * 128; i += NTHR) { const int row = i >> 7, c = i & 127; *(u32x4*)(smem + RT_W + row * RT_PITCH + c * 16) = *(const u32x4*)(btr + (size_t)row * D + c * 8); }
    for (int rb = blockIdx.x * LNROWS; rb < NTOK; rb += gridDim.x * LNROWS) {
        const int b = rb / SEQ, r0 = rb + wv * RPW;
        __syncthreads();
        lds_vec_fill(0, p.ln1_g + l * D, tid_); lds_vec_fill(1, p.ln1_b + l * D, tid_);
        lds_vec_fill(2, mod + (size_t)b * 6144 + 2048, tid_); lds_vec_fill(3, mod + (size_t)b * 6144 + 3072, tid_); lds_vec_fill(4, mod + (size_t)b * 6144 + 4096, tid_);
        if (tid_ < 32) hist[tid_] = 0u;
        __syncthreads();
        auto ldrow = [&](int row, In& q) {
            if (XBF) ldraw(q.xr, xb + (size_t)row * D, lane); else ldvec(q.x, p.x + (size_t)row * D, lane);
            ldraw(q.m, mix + (size_t)row * D, lane);
        };
        auto form = [&](In& q, f32x4 (&v)[4]) {
            RowVec xv, mv; if (XBF) raw2vec(xv, q.xr); else xv = q.x; raw2vec(mv, q.m);
#pragma unroll
            for (int i = 0; i < 4; ++i) v[i] = xv.v[i] * ALPHA + (lv(2, i, lane) + 1.0f) * mv.v[i];
        };
        unsigned pk[RPW / 4]; float ga[RPW / 4];
        In c0, c1;
        ldrow(r0, c0); ldrow(r0 + 1, c1);
#pragma unroll
        for (int k = 0; k < RPW; k += 2) {
            const int row = r0 + k;
            f32x4 va[4], vb[4]; form(c0, va); form(c1, vb);
            if (k + 2 < RPW) { ldrow(row + 2, c0); ldrow(row + 3, c1); }
            float mua, rsa, mub, rsb; row_stats2(va, vb, mua, rsa, mub, rsb);
            affine_lds(va, mua, rsa, 0, 1, lane); affine_lds(vb, mub, rsb, 0, 1, lane);
            stvec_bf(x1 + (size_t)row * D, va, lane); stvec_bf(x1 + (size_t)(row + 1) * D, vb, lane);
            {
                float m2a, r2a, m2b, r2b; row_stats2(va, vb, m2a, r2a, m2b, r2b);
#pragma unroll
                for (int i = 0; i < 2; ++i) {
                    u32x4 wa, wb;
#pragma unroll
                    for (int h = 0; h < 2; ++h) {
                        const f32x4 sc = lv(4, 2 * i + h, lane) + 1.0f, sh = lv(3, 2 * i + h, lane);
                        const f32x4 oa = (va[2 * i + h] - m2a) * r2a * sc + sh, ob = (vb[2 * i + h] - m2b) * r2b * sc + sh;
                        if (h == 0) { wa.x = cvtpk(oa[0], oa[1]); wa.y = cvtpk(oa[2], oa[3]); wb.x = cvtpk(ob[0], ob[1]); wb.y = cvtpk(ob[2], ob[3]); }
                        else { wa.z = cvtpk(oa[0], oa[1]); wa.w = cvtpk(oa[2], oa[3]); wb.z = cvtpk(ob[0], ob[1]); wb.w = cvtpk(ob[2], ob[3]); }
                    }
                    *(u32x4*)(hb + (size_t)row * D + 512 * i + 8 * lane) = wa; *(u32x4*)(hb + (size_t)(row + 1) * D + 512 * i + 8 * lane) = wb;
                    *(u32x4*)(stg + (k & 2) * RT_PITCH + (512 * i + 8 * lane) * 2) = wa; *(u32x4*)(stg + ((k & 2) + 1) * RT_PITCH + (512 * i + 8 * lane) * 2) = wb;
                }
            }
            if ((k & 2) == 0) continue;
            f32x4 acc[2] = {(f32x4){0.f, 0.f, 0.f, 0.f}, (f32x4){0.f, 0.f, 0.f, 0.f}};
            const bool arow_ok = fr < 4;
            const char* ap = stg + (fr & 3) * RT_PITCH + fq * 16;
            const char* bp = smem + RT_W + fr * RT_PITCH + fq * 16;
#pragma unroll 8
            for (int ks = 0; ks < 32; ++ks) {
                u32x4 aw = *(const u32x4*)(ap + ks * 64);
                if (!arow_ok) aw = (u32x4){0u, 0u, 0u, 0u};
                const bf16x8 af = __builtin_bit_cast(bf16x8, aw);
                const bf16x8 b0 = *(const bf16x8*)(bp + ks * 64), b1 = *(const bf16x8*)(bp + 16 * RT_PITCH + ks * 64);
                acc[0] = MFMA16(b0, af, acc[0]); acc[1] = MFMA16(b1, af, acc[1]);
            }
            {
                float sc[8], bs[8];
#pragma unroll
                for (int i = 0; i < 8; ++i) { sc[i] = sigmoidf_(acc[i >> 2][i & 3]); bs[i] = sc[i] + rbias[(i >> 2) * 16 + 4 * fq + (i & 3)]; }
                float gsv[2];
#pragma unroll
                for (int g = 0; g < 2; ++g) {
                    const float a_ = bs[4 * g], b_ = bs[4 * g + 1], c_ = bs[4 * g + 2], d_ = bs[4 * g + 3];
                    const float h1 = fmaxf(a_, b_), l1 = fminf(a_, b_), h2 = fmaxf(c_, d_), l2 = fminf(c_, d_);
                    gsv[g] = fmaxf(h1, h2) + fmaxf(fminf(h1, h2), fmaxf(l1, l2));
                }
                float best = gsv[0]; int bg = fq;
                if (gsv[1] > gsv[0]) { best = gsv[1]; bg = 4 + fq; }
#pragma unroll
                for (int off = 16; off <= 32; off <<= 1) {
                    const float ob = __shfl_xor(best, off); const int og = __shfl_xor(bg, off);
                    if (ob > best || (ob == best && og < bg)) { best = ob; bg = og; }
                }
                pk[k >> 2] = 0u; ga[k >> 2] = 0.f;
                if (arow_ok && (bg & 3) == fq) {
                    const bool up = bg >= 4;
                    float s4[4], b4[4];
#pragma unroll
                    for (int jj = 0; jj < 4; ++jj) { s4[jj] = up ? sc[4 + jj] : sc[jj]; b4[jj] = up ? bs[4 + jj] : bs[jj]; }
                    int i0 = 0; float v0 = b4[0];
#pragma unroll
                    for (int jj = 1; jj < 4; ++jj) if (b4[jj] > v0) { v0 = b4[jj]; i0 = jj; }
                    int i1 = 0; float v1 = -1e30f;
#pragma unroll
                    for (int jj = 0; jj < 4; ++jj) if (jj != i0 && b4[jj] > v1) { v1 = b4[jj]; i1 = jj; }
                    const float sa = i0 == 0 ? s4[0] : i0 == 1 ? s4[1] : i0 == 2 ? s4[2] : s4[3];
                    const float sb = i1 == 0 ? s4[0] : i1 == 1 ? s4[1] : i1 == 2 ? s4[2] : s4[3];
                    ga[k >> 2] = sa / (sa + sb);
                    const unsigned e0 = 4 * bg + i0, e1 = 4 * bg + i1;
                    const unsigned ls0 = atomicAdd(&hist[e0], 1u), ls1 = atomicAdd(&hist[e1], 1u);
                    pk[k >> 2] = e0 | (e1 << 5) | (ls0 << 10) | (ls1 << 19) | (1u << 28);
                }
            }
        }
        __syncthreads();
        if (tid_ < 32) hist[32 + tid_] = atomicAdd(&cnt[64 * tid_], hist[tid_]);
        __syncthreads();
#pragma unroll
        for (int q = 0; q < RPW / 4; ++q) {
            if (pk[q] >> 28) {
                const int tok = r0 + 4 * q + fr;
                const int e0 = pk[q] & 31, e1 = (pk[q] >> 5) & 31;
                const int s0 = (int)hist[32 + e0] + (int)((pk[q] >> 10) & 511), s1 = (int)hist[32 + e1] + (int)((pk[q] >> 19) & 511);
                tes[tok * 2] = (e0 << 24) | s0; tes[tok * 2 + 1] = (e1 << 24) | s1;
                tg[tok * 2] = ga[q]; tg[tok * 2 + 1] = 1.0f - ga[q];
                list[(size_t)e0 * NTOK + s0] = tok; list[(size_t)e1 * NTOK + s1] = tok;
            }
        }
    }
    __syncthreads();
}

DI void phase_ln2(const Params& p, int l, float* xout) {
    const int tid_ = otid(), lane = tid_ & 63, wv = tid_ >> 6;
    const float* mod = (const float*)(p.ws + WS_MOD) + (size_t)l * NB * 6144;
    const bf16_t* x1 = (const bf16_t*)(p.ws + WS_X1);
    bf16_t* xb = (bf16_t*)(p.ws + WS_XB);
    const bf16_t* ys = (const bf16_t*)(p.ws + WS_YS);
    const int* tes = (const int*)(p.ws + WS_TOKES);
    const float* tg = (const float*)(p.ws + WS_TOKG);
    const unsigned* ebase = (const unsigned*)(p.ws + WS_CTL) + CW_BASE + l * 64;
    bf16_t* hb = (bf16_t*)(p.ws + WS_HBUF);
    const float* modn = (const float*)(p.ws + WS_MOD) + (size_t)(l + 1 < DEPTH ? l + 1 : l) * NB * 6144;
    struct In { RowRaw x, y0, y1; };
    for (int rb = blockIdx.x * LNROWS; rb < NTOK; rb += gridDim.x * LNROWS) {
        const int b = rb / SEQ, r0 = rb + wv * RPW;
        __syncthreads();
        lds_vec_fill(0, p.ln2_g + l * D, tid_); lds_vec_fill(1, p.ln2_b + l * D, tid_);
        lds_vec_fill(2, mod + (size_t)b * 6144 + 5120, tid_); lds_vec_fill(3, modn + (size_t)b * 6144, tid_); lds_vec_fill(4, modn + (size_t)b * 6144 + 1024, tid_);
        __syncthreads();
        int es = 0; float gv = 0.f;
        if (lane < 2 * RPW) { es = tes[(size_t)r0 * 2 + lane]; gv = tg[(size_t)r0 * 2 + lane]; es = (int)(ebase[es >> 24] + (unsigned)(es & 0xffffff)); }
        auto ldrow = [&](int k, In& q) {
            const size_t p0 = (size_t)__shfl(es, 2 * k), p1 = (size_t)__shfl(es, 2 * k + 1);
            ldraw(q.x, x1 + (size_t)(r0 + k) * D, lane); ldraw(q.y0, ys + p0 * D, lane); ldraw(q.y1, ys + p1 * D, lane);
        };
        auto form = [&](int k, const In& q, f32x4 (&v)[4]) {
            const float g0 = __shfl(gv, 2 * k), g1 = __shfl(gv, 2 * k + 1);
            RowVec xv, a0, a1; raw2vec(xv, q.x); raw2vec(a0, q.y0); raw2vec(a1, q.y1);
#pragma unroll
            for (int i = 0; i < 4; ++i) v[i] = xv.v[i] * ALPHA + (lv(2, i, lane) + 1.0f) * (a0.v[i] * g0 + a1.v[i] * g1);
        };
        In c0, c1;
        ldrow(0, c0); ldrow(1, c1);
#pragma unroll 1
        for (int k = 0; k < RPW; k += 2) {
            const int row = r0 + k;
            f32x4 va[4], vb[4]; form(k, c0, va); form(k + 1, c1, vb);
            if (k + 2 < RPW) { ldrow(k + 2, c0); ldrow(k + 3, c1); }
            float mua, rsa, mub, rsb; row_stats2(va, vb, mua, rsa, mub, rsb);
            affine_lds(va, mua, rsa, 0, 1, lane); affine_lds(vb, mub, rsb, 0, 1, lane);
            if (l + 1 < DEPTH) {
                stvec_bf(xb + (size_t)row * D, va, lane); stvec_bf(xb + (size_t)(row + 1) * D, vb, lane);
                modulate_store2(va, vb, 3, 4, hb + (size_t)row * D, hb + (size_t)(row + 1) * D, lane);
            } else {
                stvec_f32(xout + (size_t)row * D, va, lane); stvec_f32(xout + (size_t)(row + 1) * D, vb, lane);
            }
        }
    }
}

DI int unit_id(int r) {
    const int g8 = gridDim.x >> 3;
    if ((gridDim.x & 7) != 0) return r * gridDim.x + blockIdx.x;
    return (r * 8 + (blockIdx.x & 7)) * g8 + (blockIdx.x >> 3);
}
DI void st4bf(bf16_t* pz, float a, float b, float c, float d) { u32x2 w; w.x = cvtpk(a, b); w.y = cvtpk(c, d); *(u32x2*)pz = w; }
DI void st4bf(bf16_t* pz, const f32x4& v) { st4bf(pz, v[0], v[1], v[2], v[3]); }
typedef f32x4 acc_t[8][4];
DI int prow(int R) { const int q = R & 31; return (R & ~31) | (8 * ((q & 15) >> 2) + 4 * (q >> 4) + (q & 3)); }
template <int NQ, class Conv, class Dst>
DI void epi_staged(char* F, int wr, int wc, int fr, int fq, const Conv& conv, const Dst& dst) {
    constexpr int CPRW = 16 * NQ;
#pragma unroll
    for (int h = 0; h < 2; ++h) {
#pragma unroll
        for (int mm = 0; mm < 4; ++mm)
#pragma unroll
            for (int q = 0; q < NQ; ++q) {
                const int m = 4 * h + mm;
                f32x4 a, b; conv(m, q, a, b);
                const int row = wr * 64 + mm * 16 + fr, c16 = wc * (4 * NQ) + q * 4 + fq;
                u32x4 w; w.x = cvtpk(a[0], a[1]); w.y = cvtpk(a[2], a[3]); w.z = cvtpk(b[0], b[1]); w.w = cvtpk(b[2], b[3]);
                *(u32x4*)(F + row * (CPRW * 16) + ((c16 ^ (row & (CPRW - 1))) * 16)) = w;
            }
        __syncthreads();
        {
            const int t = otid(), c16 = t & (CPRW - 1), r0 = t / CPRW;
#pragma unroll
            for (int k = 0; k < 128 * CPRW / NTHR; ++k) {
                const int row = r0 + k * (NTHR / CPRW);
                bf16_t* d = dst((row >> 6) * 128 + h * 64 + (row & 63), c16);
                const u32x4 w = *(const u32x4*)(F + row * (CPRW * 16) + ((c16 ^ (row & (CPRW - 1))) * 16));
                if (d) *(u32x4*)d = w;
            }
        }
        __syncthreads();
    }
}
DI void st8bf(bf16_t* pz, const f32x4& a, const f32x4& b) { u32x4 w; w.x = cvtpk(a[0], a[1]); w.y = cvtpk(a[2], a[3]); w.z = cvtpk(b[0], b[1]); w.w = cvtpk(b[2], b[3]); *(u32x4*)pz = w; }

constexpr int SL_STAGE = 49152, SL_B = 16384;
template <int MB, int NQ, class ARow, class BRow, class Conv, class Dst>
DI void gemm_slice(const char* abase, const char* bbase, const int KT, const ARow& arow, const BRow& brow, const Conv& conv, const Dst& dst) {
    const int tid = otid(), lane = tid & 63, wid = __builtin_amdgcn_readfirstlane(tid >> 6), wr = wid >> 2, wc = wid & 3, fr = lane & 15, fq = lane >> 4;
    constexpr int NA = MB / 2;
    unsigned ao[NA], bo[4];
#pragma unroll
    for (int i = 0; i < 4; ++i) { int R, C; stage_rc(wid * 1024 + i * 8192 + lane * 16, R, C); bo[i] = brow(R) + 2 * C; if (i < NA) ao[i] = arow(R) + 2 * C; }
#define SL_STAGE_IN(s, kt) do { _Pragma("unroll") for (int i = 0; i < 4; ++i) { \
        if (i < NA) __builtin_amdgcn_global_load_lds((const unsigned*)(abase + ao[i < NA ? i : 0] + (kt) * 128), (unsigned*)(smem + (s) * SL_STAGE + wid * 1024 + i * 8192), 16, 0, 0); \
        __builtin_amdgcn_global_load_lds((const unsigned*)(bbase + bo[i] + (kt) * 128), (unsigned*)(smem + (s) * SL_STAGE + SL_B + wid * 1024 + i * 8192), 16, 0, 0); } } while (0)
    f32x4 acc[MB][4];
#pragma unroll
    for (int m = 0; m < MB; ++m)
#pragma unroll
        for (int n = 0; n < 4; ++n) acc[m][n] = (f32x4){0.f, 0.f, 0.f, 0.f};
    __syncthreads();
    SL_STAGE_IN(0, 0);
    if (KT > 1) SL_STAGE_IN(1, 1);
    int cs = 0;
#pragma unroll 1
    for (int t = 0; t < KT; ++t) {
        if (t + 1 < KT) { if (NA == 1) asm volatile("s_waitcnt vmcnt(5)" ::: "memory"); else asm volatile("s_waitcnt vmcnt(6)" ::: "memory"); }
        else asm volatile("s_waitcnt vmcnt(0)" ::: "memory");
        __syncthreads();
        const int ns = cs == 0 ? 2 : cs - 1;
        if (t + 2 < KT) SL_STAGE_IN(ns, t + 2);
        const char* sa = smem + cs * SL_STAGE; const char* sb = sa + SL_B;
        bf16x8 At[2][MB], Bf[2][4];
#pragma unroll
        for (int ks = 0; ks < 2; ++ks) {
#pragma unroll
            for (int n = 0; n < 4; ++n) Bf[ks][n] = *(const bf16x8*)(sb + lds_byte(wc * 64 + n * 16 + fr, ks * 32 + fq * 8));
#pragma unroll
            for (int m = 0; m < MB; ++m) At[ks][m] = *(const bf16x8*)(sa + lds_byte(wr * (16 * MB) + m * 16 + fr, ks * 32 + fq * 8));
        }
#pragma unroll
        for (int ks = 0; ks < 2; ++ks)
#pragma unroll
            for (int m = 0; m < MB; ++m)
#pragma unroll
                for (int n = 0; n < 4; ++n) acc[m][n] = MFMA16(Bf[ks][n], At[ks][m], acc[m][n]);
        cs = cs == 2 ? 0 : cs + 1;
    }
#undef SL_STAGE_IN
    __syncthreads();
    constexpr int CPRW = 16 * NQ, R = 32 * MB;
    char* F = smem;
#pragma unroll
    for (int m = 0; m < MB; ++m)
#pragma unroll
        for (int q = 0; q < NQ; ++q) {
            f32x4 a, b; conv(acc, m, q, a, b);
            const int row = wr * (16 * MB) + m * 16 + fr, c16 = wc * (4 * NQ) + q * 4 + fq;
            u32x4 w; w.x = cvtpk(a[0], a[1]); w.y = cvtpk(a[2], a[3]); w.z = cvtpk(b[0], b[1]); w.w = cvtpk(b[2], b[3]);
            *(u32x4*)(F + row * (CPRW * 16) + ((c16 ^ (row & (CPRW - 1))) * 16)) = w;
        }
    __syncthreads();
    {
        const int t = otid(), c16 = t & (CPRW - 1), r0 = t / CPRW;
#pragma unroll
        for (int k = 0; k < R * CPRW / NTHR; ++k) {
            const int row = r0 + k * (NTHR / CPRW);
            bf16_t* d = dst(row, c16);
            const u32x4 w = *(const u32x4*)(F + row * (CPRW * 16) + ((c16 ^ (row & (CPRW - 1))) * 16));
            if (d) *(u32x4*)d = w;
        }
    }
    __syncthreads();
}

struct UG1 { int m0, nt; };
DI void phase_gemm1(const Params& p, int l) {
    unsigned char* ws = p.ws;
    const bf16_t* hb = (const bf16_t*)(ws + WS_HBUF);
    const bf16_t* bt = (const bf16_t*)(ws + WS_BTIN) + (size_t)l * INWP * D;
    bf16_t* sbq = (bf16_t*)(ws + WS_SBQ); bf16_t* lat = (bf16_t*)(ws + WS_LAT);
    static_assert(WS_SBK == WS_SBQ + (size_t)NTOK * 1024 && WS_SBV == WS_SBK + (size_t)NTOK * 1024, "sbq|sbk|sbv must be consecutive");
    float* rstd = (float*)(ws + WS_RSTD);
    const float* cs = (const float*)(ws + WS_CS);
    float* rowss = (float*)(smem + LDS_AUX + AUX_ROWSS);
    constexpr int NTL = (NTOK / 256) * 8;
    auto get = [=](int r, UG1& u) { const int t = unit_id(r); if (t >= NTL) return false; u.m0 = (t >> 3) * 256; u.nt = (t + r) & 7; return true; };
    auto arow = [=](const UG1& u, int r) { return (unsigned)(u.m0 + r) * (D * 2u); };
    auto brow = [=](const UG1& u, int r) { return (unsigned)(u.nt * 256 + prow(r)) * (D * 2u); };
    auto kf = [=](const UG1&) { return D; };
    auto epi = [=](const UG1& u, const acc_t& acc, int wr, int wc, int fr, int fq, char* F) {
        const int m0 = u.m0, nt = u.nt, n0 = nt * 256;
        if (nt < 6) {
            const float sc = nt < 2 ? 0.125f * LOG2E : 1.0f;
            bf16_t* dstb = sbq + (size_t)(nt >> 1) * ((size_t)NTOK * 512) + (n0 & 511);
            epi_staged<2>(F, wr, wc, fr, fq,
                [&](int m, int q, f32x4& a, f32x4& b) { a = acc[m][2 * q] * sc; b = acc[m][2 * q + 1] * sc; },
                [&](int row, int c16) { return dstb + (size_t)(m0 + row) * 512 + c16 * 8; });
        } else {
            if (otid() < 256) rowss[otid()] = 0.f;
            __syncthreads();
#pragma unroll
            for (int m = 0; m < 8; ++m) {
                const int tl = wr * 128 + m * 16 + fr;
                float ssq = 0.f;
#pragma unroll
                for (int q = 0; q < 2; ++q) {
                    const int c = (n0 - 1536) + wc * 64 + q * 32 + 8 * fq;
                    const f32x4 a0 = acc[m][2 * q], a1 = acc[m][2 * q + 1];
                    if (nt == 6 || c < 384) ssq += ((a0[0] * a0[0] + a0[1] * a0[1]) + (a0[2] * a0[2] + a0[3] * a0[3])) + ((a1[0] * a1[0] + a1[1] * a1[1]) + (a1[2] * a1[2] + a1[3] * a1[3]));
                }
                ssq += __shfl_xor(ssq, 16); ssq += __shfl_xor(ssq, 32);
                if (fq == 0 && (nt == 6 || wc < 2)) atomicAdd(&rowss[tl], ssq);
            }
            const bool ropew = nt == 7 && wc == 2;
            const int ci = (8 * fq) & 15;
            epi_staged<2>(F, wr, wc, fr, fq,
                [&](int m, int q, f32x4& a, f32x4& b) {
                    a = acc[m][2 * q]; b = acc[m][2 * q + 1];
                    if (ropew && q == 0) {
                        const float* c = cs + ((size_t)m0 + wr * 128 + m * 16 + fr) * 32;
                        const f32x4 c0 = *(const f32x4*)(c + ci), c1 = *(const f32x4*)(c + ci + 4), s0 = *(const f32x4*)(c + 16 + ci), s1 = *(const f32x4*)(c + 16 + ci + 4);
                        f32x4 pa, pb;
#pragma unroll
                        for (int i = 0; i < 4; ++i) { pa[i] = xhalf(a[i]); pb[i] = xhalf(b[i]); }
                        if (fq < 2) { a = a * c0 - pa * s0; b = b * c1 - pb * s1; }
                        else        { a = pa * s0 + a * c0; b = pb * s1 + b * c1; }
                    }
                },
                [&](int row, int c16) { const int c = (n0 - 1536) + c16 * 8; return c < LATW ? lat + (size_t)(m0 + row) * LATW + c : (bf16_t*)nullptr; });
            if (otid() < 256) rstd[(size_t)(nt - 6) * NTOK + m0 + otid()] = __builtin_amdgcn_rsqf(rowss[otid()] * (nt == 6 ? 1.0f / 256.0f : 1.0f / 128.0f) + 1e-6f);
        }
    };
    auto ko = [=](const UG1& u) { return u.nt * 2; };
    gemm_stream<UG1>((const char*)hb, (const char*)bt, get, arow, brow, kf, ko, epi);
}

struct UG3 { int m0, j; };
DI void phase_mlaprep(const Params& p, int l) {
    unsigned char* ws = p.ws;
    const bf16_t* lat = (const bf16_t*)(ws + WS_LAT);
    const bf16_t* btq = (const bf16_t*)(ws + WS_BTUQ) + (size_t)l * 768 * 256;
    const bf16_t* btkv = (const bf16_t*)(ws + WS_BTUKV) + (size_t)l * 1024 * 128;
    bf16_t* qm = (bf16_t*)(ws + WS_QM); bf16_t* km = (bf16_t*)(ws + WS_KM);
    const float* cs = (const float*)(ws + WS_CS);
    const float* rstd_q = (const float*)(ws + WS_RSTD); const float* rstd_kv = rstd_q + NTOK;
    constexpr int NTL = (NTOK / 256) * 7;
    auto get = [=](int r, UG3& u) { const int t = unit_id(r); if (t >= NTL) return false; u.m0 = (t / 7) * 256; u.j = t % 7; return true; };
    const unsigned kvoff = (unsigned)((const char*)btkv - (const char*)btq);
    auto arow = [=](const UG3& u, int r) { return (unsigned)(u.m0 + r) * (LATW * 2u) + (u.j < 3 ? 0u : 512u); };
    auto brow = [=](const UG3& u, int r) { return u.j < 3 ? (unsigned)(u.j * 256 + prow(r)) * 512u : kvoff + (unsigned)((u.j - 3) * 256 + prow(r)) * 256u; };
    auto kf = [=](const UG3& u) { return u.j < 3 ? 256 : 128; };
    auto epi = [=](const UG3& u, const acc_t& acc, int wr, int wc, int fr, int fq, char* F) {
        const int m0 = u.m0, j = u.j;
        const float* rsp = j < 3 ? rstd_q : rstd_kv;
        const float qs = j < 3 ? 0.10206207261596575f * LOG2E : 1.0f;
        float rs[8];
#pragma unroll
        for (int m = 0; m < 8; ++m) rs[m] = rsp[(size_t)m0 + wr * 128 + m * 16 + fr] * qs;
        bf16_t* dbase = j < 3 ? qm + j * 256 : km + (j - 3) * 256;
        const int dpitch = j < 3 ? 768 : 1024;
        epi_staged<2>(F, wr, wc, fr, fq,
            [&](int m, int q, f32x4& a, f32x4& b) { a = acc[m][2 * q] * rs[m]; b = acc[m][2 * q + 1] * rs[m]; },
            [&](int row, int c16) { return dbase + (size_t)(m0 + row) * dpitch + c16 * 8; });
    };
    auto ko = [=](const UG3& u) { return u.j; };
    gemm_stream<UG3>((const char*)lat, (const char*)btq, get, arow, brow, kf, ko, epi);
}

struct UG5 { int m0, n0; };
DI void phase_wo(const Params& p, int l) {
    unsigned char* ws = p.ws;
    const bf16_t* mg = (const bf16_t*)(ws + WS_HBUF);
    const bf16_t* bt = (const bf16_t*)(ws + WS_BTO) + (size_t)l * D * D;
    bf16_t* mix = (bf16_t*)(ws + WS_MIX);
    constexpr int NTL = (NTOK / 256) * 4;
    auto get = [=](int r, UG5& u) { const int t = unit_id(r); if (t >= NTL) return false; u.m0 = (t >> 2) * 256; u.n0 = (t & 3) * 256; return true; };
    auto arow = [=](const UG5& u, int r) { return (unsigned)(u.m0 + r) * (D * 2u); };
    auto brow = [=](const UG5& u, int r) { return (unsigned)(u.n0 + prow(r)) * (D * 2u); };
    auto kf = [=](const UG5&) { return D; };
    auto epi = [=](const UG5& u, const acc_t& acc, int wr, int wc, int fr, int fq, char* F) {
        epi_staged<2>(F, wr, wc, fr, fq,
            [&](int m, int q, f32x4& a, f32x4& b) { a = acc[m][2 * q]; b = acc[m][2 * q + 1]; },
            [&](int row, int c16) { return mix + (size_t)(u.m0 + row) * D + u.n0 + c16 * 8; });
    };
    auto ko = [=](const UG5& u) { return u.n0 >> 6; };
    gemm_stream<UG5>((const char*)mg, (const char*)bt, get, arow, brow, kf, ko, epi);
}

DI void moe_sched(const Params& p, int l) {
    const unsigned* cnt = (const unsigned*)(p.ws + WS_CTL) + CW_CNT + l * 2048;
    int* cnts = (int*)(smem + LDS_AUX + AUX_CNTS); int* mts = (int*)(smem + LDS_AUX + AUX_MTS); int* rbs = (int*)(smem + LDS_AUX + AUX_RBS);
    __syncthreads();
    if (otid() < 32) cnts[otid()] = (int)cnt[64 * otid()];
    __syncthreads();
    if (otid() == 0) {
        int a = 0, b = 0;
        for (int e = 0; e < 32; ++e) { mts[e] = a; rbs[e] = b; a += (cnts[e] + 255) >> 8; b += cnts[e]; }
        mts[32] = a; rbs[32] = b;
    }
    __syncthreads();
}
struct UGM { int e, mt, nt, ce, rb; };
DI bool moe_unit(int u, int nsh, UGM& o) {
    const int* cnts = (const int*)(smem + LDS_AUX + AUX_CNTS); const int* mts = (const int*)(smem + LDS_AUX + AUX_MTS); const int* rbs = (const int*)(smem + LDS_AUX + AUX_RBS);
    if (u >= (mts[32] << nsh)) return false;
    const int mtg = u >> nsh; int e = 0;
    for (int i = 1; i < 32; ++i) if (mts[i] <= mtg) e = i;
    o.e = e; o.mt = mtg - mts[e]; o.nt = u & ((1 << nsh) - 1); o.ce = cnts[e]; o.rb = rbs[e];
    return true;
}

DI void phase_moe1(const Params& p, int l) {
    unsigned char* ws = p.ws;
    moe_sched(p, l);
    const int* rbs = (const int*)(smem + LDS_AUX + AUX_RBS);
    if (blockIdx.x == 0 && otid() < 32) ((unsigned*)(ws + WS_CTL))[CW_BASE + l * 64 + otid()] = (unsigned)rbs[otid()];
    const bf16_t* hb = (const bf16_t*)(ws + WS_HBUF);
    const int* list = (const int*)(ws + WS_LIST);
    bf16_t* act = (bf16_t*)(ws + WS_ACT);
    const bf16_t* btl = (const bf16_t*)(ws + WS_BTGU) + (size_t)l * NEXP * 512 * D;
    const int G = gridDim.x, total = ((const int*)(smem + LDS_AUX + AUX_MTS))[32] * 2;
    const int full = total / G, n3 = total - full * G;
    const bool split = l + 1 == DEPTH && n3 > 0 && 4 * n3 <= G;
    auto get = [=](int r, UGM& u) { if (split && r >= full) return false; return moe_unit(unit_id(r), 1, u); };
    auto arow = [=](const UGM& u, int r) { int s = u.mt * 256 + r; s = s < u.ce ? s : u.ce - 1; return (unsigned)list[(size_t)u.e * NTOK + s] * (D * 2u); };
    auto brow = [=](const UGM& u, int r) { return (unsigned)(u.e * 512 + u.nt * 256 + prow(r)) * (D * 2u); };
    auto kf = [=](const UGM&) { return D; };
    auto epi = [=](const UGM& u, const acc_t& acc, int wr, int wc, int fr, int fq, char* F) {
        epi_staged<1>(F, wr, wc, fr, fq,
            [&](int m, int, f32x4& a, f32x4& b) {
#pragma unroll
                for (int jj = 0; jj < 4; ++jj) { const float g0 = acc[m][0][jj], u0 = acc[m][2][jj], g1 = acc[m][1][jj], u1 = acc[m][3][jj]; a[jj] = g0 * sigmoidf_(g0) * u0; b[jj] = g1 * sigmoidf_(g1) * u1; }
            },
            [&](int row, int c16) { const int s = u.mt * 256 + row; return s < u.ce ? act + (size_t)(u.rb + s) * DEXP + u.nt * 128 + c16 * 8 : (bf16_t*)nullptr; });
    };
    auto ko = [=](const UGM& u) { return u.nt * 8; };
    gemm_stream<UGM>((const char*)hb, (const char*)btl, get, arow, brow, kf, ko, epi);
    if (split) {
        const int v = unit_id(0);
        UGM u;
        if (v < 4 * n3 && moe_unit(full * G + (v >> 2), 1, u)) {
            const int sr = u.mt * 256 + (v & 3) * 64;
            if (sr < u.ce)
                gemm_slice<2, 1>((const char*)hb, (const char*)btl, D / 64,
                    [=](int r) { int s = sr + r; s = s < u.ce ? s : u.ce - 1; return (unsigned)list[(size_t)u.e * NTOK + s] * (D * 2u); },
                    [=](int r) { return (unsigned)(u.e * 512 + u.nt * 256 + prow(r)) * (D * 2u); },
                    [=](const f32x4 (&acc)[2][4], int m, int, f32x4& a, f32x4& b) {
#pragma unroll
                        for (int jj = 0; jj < 4; ++jj) { const float g0 = acc[m][0][jj], u0 = acc[m][2][jj], g1 = acc[m][1][jj], u1 = acc[m][3][jj]; a[jj] = g0 * sigmoidf_(g0) * u0; b[jj] = g1 * sigmoidf_(g1) * u1; }
                    },
                    [=](int row, int c16) { const int s = sr + row; return s < u.ce ? act + (size_t)(u.rb + s) * DEXP + u.nt * 128 + c16 * 8 : (bf16_t*)nullptr; });
        }
    }
    if (l + 1 < DEPTH) {
        const int v = unit_id(0);
        int first, stride;
        if (n3 == 0) { first = v; stride = G; } else { first = v - n3; stride = G - n3; }
        if (first >= 0) conv_run(p, l + 1, false, first, stride);
    }
}

DI void phase_moe2(const Params& p, int l) {
    unsigned char* ws = p.ws;
    moe_sched(p, l);
    const bf16_t* act = (const bf16_t*)(ws + WS_ACT);
    bf16_t* ys = (bf16_t*)(ws + WS_YS);
    const bf16_t* btl = (const bf16_t*)(ws + WS_BTD) + (size_t)l * NEXP * D * DEXP;
    const int G = gridDim.x, total = ((const int*)(smem + LDS_AUX + AUX_MTS))[32] * 4;
    const int full = total / G, n3 = total - full * G;
    const int nsl = n3 == 0 ? 1 : 4 * n3 <= G ? 4 : 2 * n3 <= G ? 2 : 1;
    auto get = [=](int r, UGM& u) { if (nsl > 1 && r >= full) return false; return moe_unit(unit_id(r), 2, u); };
    auto arow = [=](const UGM& u, int r) { int s = u.mt * 256 + r; s = s < u.ce ? s : u.ce - 1; return (unsigned)(u.rb + s) * (DEXP * 2u); };
    auto brow = [=](const UGM& u, int r) { return (unsigned)(u.e * D + u.nt * 256 + prow(r)) * (DEXP * 2u); };
    auto kf = [=](const UGM&) { return DEXP; };
    auto epi = [=](const UGM& u, const acc_t& acc, int wr, int wc, int fr, int fq, char* F) {
        epi_staged<2>(F, wr, wc, fr, fq,
            [&](int m, int q, f32x4& a, f32x4& b) { a = acc[m][2 * q]; b = acc[m][2 * q + 1]; },
            [&](int row, int c16) { const int s = u.mt * 256 + row; return s < u.ce ? ys + (size_t)(u.rb + s) * D + u.nt * 256 + c16 * 8 : (bf16_t*)nullptr; });
    };
    auto ko = [=](const UGM& u) { return u.nt; };
    gemm_stream<UGM>((const char*)act, (const char*)btl, get, arow, brow, kf, ko, epi);
    if (nsl > 1) {
        const int v = unit_id(0);
        UGM u;
        if (v < nsl * n3 && moe_unit(full * G + v / nsl, 2, u)) {
            const int sr = u.mt * 256 + (v % nsl) * (256 / nsl);
            if (sr < u.ce) {
                auto sarow = [=](int r) { int s = sr + r; s = s < u.ce ? s : u.ce - 1; return (unsigned)(u.rb + s) * (DEXP * 2u); };
                auto sbrow = [=](int r) { return (unsigned)(u.e * D + u.nt * 256 + prow(r)) * (DEXP * 2u); };
                auto sdst = [=](int row, int c16) { const int s = sr + row; return s < u.ce ? ys + (size_t)(u.rb + s) * D + u.nt * 256 + c16 * 8 : (bf16_t*)nullptr; };
                if (nsl == 4) gemm_slice<2, 2>((const char*)act, (const char*)btl, DEXP / 64, sarow, sbrow, [=](const f32x4 (&acc)[2][4], int m, int q, f32x4& a, f32x4& b) { a = acc[m][2 * q]; b = acc[m][2 * q + 1]; }, sdst);
                else gemm_slice<4, 2>((const char*)act, (const char*)btl, DEXP / 64, sarow, sbrow, [=](const f32x4 (&acc)[4][4], int m, int q, f32x4& a, f32x4& b) { a = acc[m][2 * q]; b = acc[m][2 * q + 1]; }, sdst);
            }
        }
    }
}

template <int DQK, bool SBM>
DI void attn_unit(const bf16_t* __restrict__ Qb, const int qstr, const bf16_t* __restrict__ Kb, const int kstr, const bf16_t* __restrict__ Vb, const int vstr, bf16_t* Ob, const int qt,
                  const bf16_t* __restrict__ Rb = nullptr, const float* __restrict__ csb = nullptr) {
    constexpr int KSTR = DQK * 2 + 16, KBUF = 64 * KSTR, VBUF = 8192, OFF_V = 2 * KBUF;
    constexpr int CPR = DQK / 8, NCH = 64 * CPR, NKC = (NCH + NTHR - 1) / NTHR, NKS = DQK / 16;
    const int tid = otid(), lane = tid & 63, w = __builtin_amdgcn_readfirstlane(tid >> 6), r32 = lane & 31, hh = lane >> 5;
    const int q0 = qt * 256, qmin = q0 + 32 * w, myq = qmin + r32;
    const int NTL = 4 * qt + 4;
    bf16x8 qf[NKS];
#pragma unroll
    for (int ks = 0; ks < NKS; ++ks) qf[ks] = *(const bf16x8*)(Qb + (size_t)myq * qstr + ks * 16 + hh * 8);
    if (DQK == 96) {
        const float* c = csb + (size_t)myq * 32 + 8 * hh;
        const f32x4 c0 = *(const f32x4*)c, c1 = *(const f32x4*)(c + 4), s0 = *(const f32x4*)(c + 16), s1 = *(const f32x4*)(c + 20);
        const u32x4 w1 = __builtin_bit_cast(u32x4, qf[NKS - 2]), w2 = __builtin_bit_cast(u32x4, qf[NKS - 1]);
        const f32x4 t1a = bf4(w1.x, w1.y), t1b = bf4(w1.z, w1.w), t2a = bf4(w2.x, w2.y), t2b = bf4(w2.z, w2.w);
        const f32x4 o1a = t1a * c0 - t2a * s0, o1b = t1b * c1 - t2b * s1, o2a = t1a * s0 + t2a * c0, o2b = t1b * s1 + t2b * c1;
        u32x4 r1, r2;
        r1.x = cvtpk(o1a[0], o1a[1]); r1.y = cvtpk(o1a[2], o1a[3]); r1.z = cvtpk(o1b[0], o1b[1]); r1.w = cvtpk(o1b[2], o1b[3]);
        r2.x = cvtpk(o2a[0], o2a[1]); r2.y = cvtpk(o2a[2], o2a[3]); r2.z = cvtpk(o2b[0], o2b[1]); r2.w = cvtpk(o2b[2], o2b[3]);
        qf[NKS - 2] = __builtin_bit_cast(bf16x8, r1); qf[NKS - 1] = __builtin_bit_cast(bf16x8, r2);
    }
    f32x16 o[2];
#pragma unroll
    for (int i = 0; i < 16; ++i) { o[0][i] = 0.f; o[1][i] = 0.f; }
    float mrun = 0.f, lrun = 0.f, Lrun = 1.0f;
    f32x16 negm;
#pragma unroll
    for (int i = 0; i < 16; ++i) negm[i] = 0.f;
    u32x4 rkA[NKC], rvA, rkB[NKC], rvB;
    auto gload = [&](int j, u32x4 (&rk)[NKC], u32x4& rv) {
        if (DQK == 96) {
            rk[0] = *(const u32x4*)(Kb + (size_t)(64 * j + (tid >> 3)) * kstr + (tid & 7) * 8);
            if (tid < 256) rk[NKC - 1] = *(const u32x4*)(Rb + (size_t)(64 * j + (tid >> 2)) * LATW + (tid & 3) * 8);
        } else {
#pragma unroll
            for (int i = 0; i < NKC; ++i) { const int cid = tid + NTHR * i; if (cid < NCH) { const int row = cid / CPR, c = cid % CPR; rk[i] = *(const u32x4*)(Kb + (size_t)(64 * j + row) * kstr + c * 8); } }
        }
        { const int row = tid >> 3, c = tid & 7; rv = *(const u32x4*)(Vb + (size_t)(64 * j + row) * vstr + c * 8); }
    };
    auto lstore = [&](int buf, const u32x4 (&rk)[NKC], const u32x4& rv) {
        if (DQK == 96) {
            *(u32x4*)(smem + buf * KBUF + (tid >> 3) * KSTR + (tid & 7) * 16) = rk[0];
            if (tid < 256) *(u32x4*)(smem + buf * KBUF + (tid >> 2) * KSTR + (8 + (tid & 3)) * 16) = rk[NKC - 1];
        } else {
#pragma unroll
            for (int i = 0; i < NKC; ++i) { const int cid = tid + NTHR * i; if (cid < NCH) { const int row = cid / CPR, c = cid % CPR; *(u32x4*)(smem + buf * KBUF + row * KSTR + c * 16) = rk[i]; } }
        }
        { const int row = tid >> 3, c = tid & 7; *(u32x4*)(smem + OFF_V + buf * VBUF + (c >> 2) * 4096 + row * 64 + (c & 3) * 16) = rv; }
    };
    unsigned* flags = (unsigned*)(smem + LDS_AUX + AUX_FLAGS);
#define RAW_BARRIER() asm volatile("s_waitcnt lgkmcnt(0)\n\ts_barrier" ::: "memory")
    gload(SBM ? NTL - 1 : 0, rkA, rvA); lstore(0, rkA, rvA);
    gload(SBM ? NTL - 2 : 1, rkA, rvA);
    RAW_BARRIER();
    bool done = false;
    auto step = [&](const int it, u32x4 (&rkH)[NKC], u32x4& rvH, u32x4 (&rkL)[NKC], u32x4& rvL) {
        const int j = SBM ? NTL - 1 - it : it, buf = it & 1;
        if (it + 2 < NTL) gload(SBM ? j - 2 : j + 2, rkL, rvL);
        const int kmin = 64 * j;
        const bool none = SBM ? (kmin >= qmin + 31 || !__any(Lrun > 0.f)) : (kmin > qmin + 31);
        if (!none) {
            const bool full = SBM ? (kmin + 63 < qmin) : (kmin + 63 <= qmin);
            f32x16 s[2];
            bf16x8 kf[2][NKS], vf[2][4];
#pragma unroll
            for (int ks = 0; ks < NKS; ++ks)
#pragma unroll
                for (int kb = 0; kb < 2; ++kb) kf[kb][ks] = *(const bf16x8*)(smem + buf * KBUF + (32 * kb + r32) * KSTR + ks * 32 + hh * 16);
#pragma unroll
            for (int ks = 0; ks < NKS; ++ks)
#pragma unroll
                for (int kb = 0; kb < 2; ++kb) s[kb] = MFMA(kf[kb][ks], qf[ks], ks == 0 ? negm : s[kb]);
            {
                typedef short v4i16_t __attribute__((ext_vector_type(4)));
                typedef __attribute__((address_space(3))) v4i16_t* lds_v4p;
                const int vbase = OFF_V + buf * VBUF + ((lane >> 4) & 1) * 32 + (lane & 3) * 8 + (4 * hh + ((lane & 15) >> 2)) * 64;
#pragma unroll
                for (int kx = 0; kx < 4; ++kx)
#pragma unroll
                    for (int db = 0; db < 2; ++db) {
                        const v4i16_t lo = __builtin_amdgcn_ds_read_tr16_b64_v4i16((lds_v4p)(smem + vbase + db * 4096 + kx * 1024));
                        const v4i16_t hi = __builtin_amdgcn_ds_read_tr16_b64_v4i16((lds_v4p)(smem + vbase + db * 4096 + kx * 1024 + 512));
                        vf[db][kx] = (bf16x8){lo[0], lo[1], lo[2], lo[3], hi[0], hi[1], hi[2], hi[3]};
                    }
            }
            if (!SBM) {
                if (!full) {
#pragma unroll
                    for (int kb = 0; kb < 2; ++kb)
#pragma unroll
                        for (int i = 0; i < 16; ++i) if (kmin + 32 * kb + crow(i, hh) > myq) s[kb][i] = -INFINITY;
                }
                float mx = s[0][0];
#pragma unroll
                for (int kb = 0; kb < 2; ++kb)
#pragma unroll
                    for (int i = 0; i < 16; ++i) mx = fmaxf(mx, s[kb][i]);
                mx = fmaxf(mx, xhalf(mx));
                if (it == 0 || __any(mx > 8.0f)) {
                    const float d = it == 0 ? mx : fmaxf(mx, 0.f);
                    mrun += d;
                    const float al = it == 0 ? 1.0f : fexp2(-d);
                    lrun *= al;
#pragma unroll
                    for (int kb = 0; kb < 2; ++kb)
#pragma unroll
                        for (int i = 0; i < 16; ++i) s[kb][i] -= d;
#pragma unroll
                    for (int i = 0; i < 16; ++i) { o[0][i] *= al; o[1][i] *= al; negm[i] = -mrun; }
                }
                float rs = 0.f;
#pragma unroll
                for (int kb = 0; kb < 2; ++kb)
#pragma unroll
                    for (int i = 0; i < 16; ++i) { const float pz = fexp2(s[kb][i]); s[kb][i] = pz; rs += pz; }
                lrun += rs;
            } else {
                f32x16 kp[2];
#pragma unroll
                for (int kb = 0; kb < 2; ++kb)
#pragma unroll
                    for (int i = 0; i < 16; ++i) {
                        const float u = fexp2(fminf(s[kb][i], 100.0f));
                        float k_ = frcp(1.0f + u), b_ = u * k_;
                        if (!full && !(kmin + 32 * kb + crow(i, hh) < myq)) { k_ = 1.0f; b_ = 0.f; }
                        kp[kb][i] = k_; s[kb][i] = b_;
                    }
                float run = Lrun;
#pragma unroll
                for (int kb = 1; kb >= 0; --kb)
#pragma unroll
                    for (int g = 3; g >= 0; --g) {
                        const float G = (kp[kb][4 * g] * kp[kb][4 * g + 1]) * (kp[kb][4 * g + 2] * kp[kb][4 * g + 3]);
                        const float Gp = xhalf(G);
                        float a_ = hh ? run : run * Gp;
#pragma unroll
                        for (int jl = 3; jl >= 0; --jl) {
                            const int i = 4 * g + jl;
                            s[kb][i] *= a_;
                            a_ *= kp[kb][i];
                        }
                        run *= G * Gp;
                    }
                Lrun = run;
            }
#pragma unroll
            for (int kb = 0; kb < 2; ++kb)
#pragma unroll
                for (int sx = 0; sx < 2; ++sx) {
                    u32x4 pw;
                    pw.x = cvtpk(s[kb][8 * sx], s[kb][8 * sx + 1]); pw.y = cvtpk(s[kb][8 * sx + 2], s[kb][8 * sx + 3]);
                    pw.z = cvtpk(s[kb][8 * sx + 4], s[kb][8 * sx + 5]); pw.w = cvtpk(s[kb][8 * sx + 6], s[kb][8 * sx + 7]);
                    const bf16x8 pk = __builtin_bit_cast(bf16x8, pw);
#pragma unroll
                    for (int db = 0; db < 2; ++db) o[db] = MFMA(vf[db][2 * kb + sx], pk, o[db]);
                }
        }
        if (it + 1 < NTL) lstore(buf ^ 1, rkH, rvH);
        if (SBM) { const bool alive = __any(Lrun > 0.f); if (lane == 0) flags[(it & 1) * 8 + w] = alive ? 1u : 0u; }
        RAW_BARRIER();
        if (SBM) {
            unsigned f = 0u;
#pragma unroll
            for (int q = 0; q < 8; ++q) f |= flags[(it & 1) * 8 + q];
            if (f == 0u) done = true;
        }
    };
    for (int it = 0; it < NTL && !done; it += 2) {
        step(it, rkA, rvA, rkB, rvB);
        if (done) break;
        step(it + 1, rkB, rvB, rkA, rvA);
    }
    float inv = 1.0f;
    if (!SBM) { const float lt = lrun + xhalf(lrun); inv = 1.0f / lt; }
#pragma unroll
    for (int db = 0; db < 2; ++db)
#pragma unroll
        for (int g = 0; g < 4; ++g)
            st4bf(Ob + (size_t)myq * D + 32 * db + 8 * g + 4 * hh, o[db][4 * g] * inv, o[db][4 * g + 1] * inv, o[db][4 * g + 2] * inv, o[db][4 * g + 3] * inv);
    RAW_BARRIER();
#undef RAW_BARRIER
}

DI void sb_wave(const bf16_t* __restrict__ Qb, const bf16_t* __restrict__ Kb, const bf16_t* __restrict__ Vb, bf16_t* Ob, const int Q0_) {
    const int Q0 = __builtin_amdgcn_readfirstlane(Q0_);
    const int tid = otid(), lane = tid & 63, w = __builtin_amdgcn_readfirstlane(tid >> 6), r32 = lane & 31, hh = lane >> 5;
    char* kl = smem + w * 16384; char* vl = kl + 8192;
    const int myq = Q0 + r32, jt = Q0 >> 6;
    bf16x8 qf[4];
#pragma unroll
    for (int ks = 0; ks < 4; ++ks) qf[ks] = *(const bf16x8*)(Qb + (size_t)myq * 512 + ks * 16 + hh * 8);
    f32x16 o[2];
#pragma unroll
    for (int i = 0; i < 16; ++i) { o[0][i] = 0.f; o[1][i] = 0.f; }
    float Prun = 1.0f;
    u32x4 rk[8], rv[8];
    const int lrow = lane >> 3, lc = lane & 7;
    auto gloadK = [&](int j) {
#pragma unroll
        for (int i = 0; i < 8; ++i) rk[i] = *(const u32x4*)(Kb + (size_t)(64 * j + lrow + 8 * i) * 512 + lc * 8);
    };
    auto gloadV = [&](int j, int half) {
#pragma unroll
        for (int i = 0; i < 4; ++i) rv[4 * half + i] = *(const u32x4*)(Vb + (size_t)(64 * j + lrow + 8 * (4 * half + i)) * 512 + lc * 8);
    };
    auto lstoreK = [&]() {
#pragma unroll
        for (int i = 0; i < 8; ++i) { const int row = lrow + 8 * i; *(u32x4*)(kl + row * 128 + ((lc ^ (row & 7)) * 16)) = rk[i]; }
    };
    auto lstoreV = [&]() {
#pragma unroll
        for (int i = 0; i < 8; ++i) { const int row = lrow + 8 * i; *(u32x4*)(vl + (lc >> 2) * 4096 + row * 64 + (lc & 3) * 16) = rv[i]; }
    };
    gloadK(jt); lstoreK();
    for (int j = jt; j >= 0; --j) {
        if (j > 0) gloadK(j - 1);
        gloadV(j, 0);
        const int kmin = 64 * j;
        const bool full = j != jt;
        f32x16 s[2];
        {
            bf16x8 kf[2][4];
#pragma unroll
            for (int ks = 0; ks < 4; ++ks)
#pragma unroll
                for (int kb = 0; kb < 2; ++kb) { const int row = 32 * kb + r32; kf[kb][ks] = *(const bf16x8*)(kl + row * 128 + (((2 * ks + hh) ^ (row & 7)) * 16)); }
#pragma unroll
            for (int kb = 0; kb < 2; ++kb)
#pragma unroll
                for (int i = 0; i < 16; ++i) s[kb][i] = 0.f;
#pragma unroll
            for (int ks = 0; ks < 4; ++ks)
#pragma unroll
                for (int kb = 0; kb < 2; ++kb) s[kb] = MFMA(kf[kb][ks], qf[ks], s[kb]);
        }
        gloadV(j, 1);
        f32x16 kp[2];
#pragma unroll
        for (int kb = 0; kb < 2; ++kb)
#pragma unroll
            for (int i = 0; i < 16; ++i) {
                const float u = fexp2(s[kb][i]);
                float k_ = frcp(1.0f + u), b_ = 1.0f - k_;
                if (!full && !(kmin + 32 * kb + crow(i, hh) < myq)) { k_ = 1.0f; b_ = 0.f; }
                kp[kb][i] = k_; s[kb][i] = b_;
            }
        float run = Prun;
#pragma unroll
        for (int kb = 1; kb >= 0; --kb)
#pragma unroll
            for (int g = 3; g >= 0; --g) {
                const float G = (kp[kb][4 * g] * kp[kb][4 * g + 1]) * (kp[kb][4 * g + 2] * kp[kb][4 * g + 3]);
                const float Gp = xhalf(G);
                float a_ = hh ? run : run * Gp;
#pragma unroll
                for (int jl = 3; jl >= 0; --jl) { const int i = 4 * g + jl; s[kb][i] *= a_; a_ *= kp[kb][i]; }
                run *= G * Gp;
            }
        Prun = run;
        lstoreV();
        bf16x8 vf[2][4];
        {
            typedef short v4i16_t __attribute__((ext_vector_type(4)));
            typedef __attribute__((address_space(3))) v4i16_t* lds_v4p;
            const char* vbase = vl + ((lane >> 4) & 1) * 32 + (lane & 3) * 8 + (4 * hh + ((lane & 15) >> 2)) * 64;
#pragma unroll
            for (int kx = 0; kx < 4; ++kx)
#pragma unroll
                for (int db = 0; db < 2; ++db) {
                    const v4i16_t lo = __builtin_amdgcn_ds_read_tr16_b64_v4i16((lds_v4p)(vbase + db * 4096 + kx * 1024));
                    const v4i16_t hi = __builtin_amdgcn_ds_read_tr16_b64_v4i16((lds_v4p)(vbase + db * 4096 + kx * 1024 + 512));
                    vf[db][kx] = (bf16x8){lo[0], lo[1], lo[2], lo[3], hi[0], hi[1], hi[2], hi[3]};
                }
        }
#pragma unroll
        for (int kb = 0; kb < 2; ++kb)
#pragma unroll
            for (int sx = 0; sx < 2; ++sx) {
                u32x4 pw;
                pw.x = cvtpk(s[kb][8 * sx], s[kb][8 * sx + 1]); pw.y = cvtpk(s[kb][8 * sx + 2], s[kb][8 * sx + 3]);
                pw.z = cvtpk(s[kb][8 * sx + 4], s[kb][8 * sx + 5]); pw.w = cvtpk(s[kb][8 * sx + 6], s[kb][8 * sx + 7]);
                const bf16x8 pk = __builtin_bit_cast(bf16x8, pw);
#pragma unroll
                for (int db = 0; db < 2; ++db) o[db] = MFMA(vf[db][2 * kb + sx], pk, o[db]);
            }
        if (!__any(Prun > 0.f)) break;
        if (j > 0) lstoreK();
    }
#pragma unroll
    for (int db = 0; db < 2; ++db)
#pragma unroll
        for (int g = 0; g < 4; ++g)
            st4bf(Ob + (size_t)myq * D + 32 * db + 8 * g + 4 * hh, o[db][4 * g], o[db][4 * g + 1], o[db][4 * g + 2], o[db][4 * g + 3]);
}

DI void phase_attn(const Params& p, int l) {
    unsigned char* ws = p.ws;
    int* slot = (int*)(smem + LDS_AUX + AUX_SLOT);
    bf16_t* mg = (bf16_t*)(ws + WS_HBUF);
    auto fetch = [&](unsigned* head) { int v = 0; if (otid() == 0) v = (int)__hip_atomic_fetch_add(head, 1u, __ATOMIC_RELAXED, __HIP_MEMORY_SCOPE_AGENT); return v; };
    auto share = [&](int v) { __syncthreads(); if (otid() == 0) *slot = v; __syncthreads(); return *slot; };
    {
        unsigned* head = (unsigned*)(ws + WS_CTL) + CW_ATTQ + 64 * l;
        const bf16_t* qm = (const bf16_t*)(ws + WS_QM); const bf16_t* km = (const bf16_t*)(ws + WS_KM); const bf16_t* lat = (const bf16_t*)(ws + WS_LAT); const float* cs = (const float*)(ws + WS_CS);
        int u = share(fetch(head));
        while (u < 1024) {
            const int nx = fetch(head);
            const int qt = 7 - (u >> 7), bh = u & 127, b = bh >> 3, h = bh & 7;
            const size_t t0 = (size_t)b * SEQ;
            attn_unit<96, false>(qm + t0 * 768 + h * 96, 768, km + (t0 * 8 + h) * KVREC, 8 * KVREC, km + (t0 * 8 + h) * KVREC + 64, 8 * KVREC, mg + t0 * D + 512 + h * 64, qt, lat + t0 * LATW + 384, cs + t0 * 32);
            u = share(nx);
        }
    }
    {
        unsigned* head = (unsigned*)(ws + WS_CTL) + CW_ATTQ + 64 * (l + DEPTH);
        const bf16_t* sbq = (const bf16_t*)(ws + WS_SBQ); const bf16_t* sbk = (const bf16_t*)(ws + WS_SBK); const bf16_t* sbv = (const bf16_t*)(ws + WS_SBV);
        int u = share(fetch(head));
        while (u < 1024) {
            const int nx = fetch(head);
            const int qt = 7 - (u >> 7), bh = u & 127, b = bh >> 3, h = bh & 7;
            const size_t t0 = (size_t)b * SEQ;
            sb_wave(sbq + t0 * 512 + h * 64, sbk + t0 * 512 + h * 64, sbv + t0 * 512 + h * 64, mg + t0 * D + h * 64, qt * 256 + 32 * (int)(otid() >> 6));
            u = share(nx);
        }
    }
}

#ifndef TIMEPH
#define TIMEPH -1
#endif
#define PHASE(id, call, sync) do { if (TIMEPH == (id)) ts_ = __builtin_amdgcn_s_memrealtime(); call; if ((sync) || TIMEPH == (id)) xcd_barrier(bar); \
                                   if (TIMEPH == (id)) tacc_ += __builtin_amdgcn_s_memrealtime() - ts_; } while (0)
__global__ void __launch_bounds__(NTHR, 2) fwd_kernel(Params p) {
    if (threadIdx.x == 0) *(uint4*)(smem + LDS_BAR) = make_uint4(0u, 0u, 0u, 0u);
    __syncthreads();
    XcdBarrier bar = xcd_barrier_post((unsigned*)(p.ws + WS_CTL), (volatile LAS unsigned*)(smem + LDS_BAR));
    unsigned long long ts_ = 0, tacc_ = 0;
    PHASE(0, phase0(p), true);
    PHASE(1, phase_ln0(p), true);
    for (int l = 0; l < DEPTH; ++l) {
        PHASE(2, phase_gemm1(p, l), true);
        PHASE(3, phase_mlaprep(p, l), true);
        PHASE(4, phase_attn(p, l), true);
        PHASE(5, phase_wo(p, l), true);
        PHASE(6, if (l == 0) phase_ln1<false>(p, l); else phase_ln1<true>(p, l), true);
        PHASE(8, phase_moe1(p, l), true);
        PHASE(9, phase_moe2(p, l), true);
        PHASE(10, phase_ln2(p, l, p.out), l + 1 < DEPTH);
    }
    if (TIMEPH >= 0) { const unsigned long long te = __builtin_amdgcn_s_memrealtime(); while (__builtin_amdgcn_s_memrealtime() - te < tacc_) __builtin_amdgcn_s_sleep(8); }
}

extern "C" void kernel_launch(void* const* d_in, const int* in_sizes, int n_in, void* d_out, int out_size, void* d_ws, size_t ws_size, hipStream_t stream) {
    static int grid = 0;
    if (grid == 0) {
        if (n_in != 20 || out_size != NTOK * D || ws_size < WS_END) { fprintf(stderr, "kernel_launch: unexpected shapes (n_in %d, out %d, ws %zu, need %zu)\n", n_in, out_size, ws_size, (size_t)WS_END); grid = -1; return; }
        int dev = 0, cus = 0, per_cu = 0;
        if (hipGetDevice(&dev) != hipSuccess || hipDeviceGetAttribute(&cus, hipDeviceAttributeMultiprocessorCount, dev) != hipSuccess) { grid = -1; return; }
        if (hipFuncSetAttribute((const void*)fwd_kernel, hipFuncAttributeMaxDynamicSharedMemorySize, LDS_BYTES) != hipSuccess) { fprintf(stderr, "kernel_launch: hipFuncSetAttribute failed\n"); grid = -1; return; }
        if (hipOccupancyMaxActiveBlocksPerMultiprocessor(&per_cu, (const void*)fwd_kernel, NTHR, LDS_BYTES) != hipSuccess || per_cu < 1) { fprintf(stderr, "kernel_launch: occupancy query failed (%d)\n", per_cu); per_cu = 1; }
        (void)hipGetLastError();
        grid = cus;
    }
    if (grid < 0) return;
    (void)hipMemsetAsync((char*)d_ws + WS_CTL, 0, CTL_BYTES, stream);
    Params p{};
    p.x = (const float*)d_in[0]; p.c = (const float*)d_in[1]; p.pos = (const int*)d_in[2];
    p.ada_w = (const float*)d_in[3]; p.ada_b = (const float*)d_in[4]; p.w_in = (const float*)d_in[5]; p.q_norm = (const float*)d_in[6]; p.kv_norm = (const float*)d_in[7];
    p.w_uq = (const float*)d_in[8]; p.w_ukv = (const float*)d_in[9]; p.w_o = (const float*)d_in[10]; p.ln1_g = (const float*)d_in[11]; p.ln1_b = (const float*)d_in[12];
    p.router_w = (const float*)d_in[13]; p.router_bias = (const float*)d_in[14]; p.w_gate = (const float*)d_in[15]; p.w_up = (const float*)d_in[16]; p.w_down = (const float*)d_in[17];
    p.ln2_g = (const float*)d_in[18]; p.ln2_b = (const float*)d_in[19];
    p.out = (float*)d_out; p.ws = (unsigned char*)d_ws;
    hipLaunchKernelGGL(fwd_kernel, dim3(grid), dim3(NTHR), LDS_BYTES, stream, p);
}
```

```cpp
#include <hip/hip_runtime.h>
#include <cstdio>
#include <cstdint>

typedef unsigned short bf16_t;
typedef short bf16x8 __attribute__((ext_vector_type(8)));
typedef float f32x16 __attribute__((ext_vector_type(16)));
typedef float f32x4 __attribute__((ext_vector_type(4)));
typedef float f32x2 __attribute__((ext_vector_type(2)));
typedef unsigned u32x4 __attribute__((ext_vector_type(4)));
typedef unsigned u32x2 __attribute__((ext_vector_type(2)));
typedef __bf16 bf16x2_t __attribute__((ext_vector_type(2)));
#define DI __device__ __forceinline__
#define MFMA(a, b, c) __builtin_amdgcn_mfma_f32_32x32x16_bf16((a), (b), (c), 0, 0, 0)

constexpr int D = 1024, NB = 16, SEQ = 2048, NTOK = NB * SEQ, DEPTH = 2;
constexpr int INW = 1952, INWP = 2048;
constexpr int NEXP = 32, DEXP = 256;
constexpr int LATW = 416;
constexpr float ALPHA = 1.4142135623730951f;
constexpr float LOG2E = 1.4426950408889634f;

constexpr size_t MiB = 1024 * 1024;
constexpr size_t WS_CTL = 0;
constexpr size_t CTL_BYTES = 65536;
constexpr size_t WS_SS = WS_CTL + CTL_BYTES;
constexpr size_t SS_BYTES = (size_t)DEPTH * 2 * NTOK * 4;
constexpr size_t WS_MOD = WS_SS + SS_BYTES;
constexpr size_t WS_CS = WS_MOD + (size_t)DEPTH * NB * 6144 * 4;
constexpr size_t WS_BTIN = WS_CS + (size_t)NTOK * 32 * 4;
constexpr size_t WS_BTUQ = WS_BTIN + (size_t)DEPTH * INWP * D * 2;
constexpr size_t WS_BTUKV = WS_BTUQ + (size_t)DEPTH * 768 * 256 * 2;
constexpr size_t WS_BTO = WS_BTUKV + (size_t)DEPTH * 1024 * 128 * 2;
constexpr size_t WS_BTGU = WS_BTO + (size_t)DEPTH * D * D * 2;
constexpr size_t WS_BTD = WS_BTGU + (size_t)DEPTH * NEXP * 512 * D * 2;
constexpr size_t WS_BTR = WS_BTD + (size_t)DEPTH * NEXP * D * DEXP * 2;
constexpr size_t WS_RSTD = WS_BTR + (size_t)256 * D * 2;
constexpr size_t WS_TOKES = WS_RSTD + (size_t)2 * NTOK * 4;
constexpr size_t WS_TOKG = WS_TOKES + (size_t)NTOK * 2 * 4;
constexpr size_t WS_LIST = WS_TOKG + (size_t)NTOK * 2 * 4;
constexpr size_t WS_HBUF = WS_LIST + (size_t)NEXP * NTOK * 4;
constexpr size_t WS_REG = WS_HBUF + (size_t)NTOK * D * 2;
constexpr size_t WS_SBQ = WS_REG;
constexpr size_t WS_SBK = WS_SBQ + (size_t)NTOK * 512 * 2;
constexpr size_t WS_SBV = WS_SBK + (size_t)NTOK * 512 * 2;
constexpr size_t WS_LAT = WS_SBV + (size_t)NTOK * 512 * 2;
constexpr size_t WS_QM = WS_LAT + (size_t)NTOK * LATW * 2;
constexpr size_t WS_KM = WS_QM + (size_t)NTOK * 768 * 2;
constexpr int KVREC = 128;
constexpr size_t WS_ATT_END = WS_KM + (size_t)NTOK * 8 * KVREC * 2;
constexpr size_t WS_X1 = WS_REG;
constexpr size_t WS_YS = WS_X1 + (size_t)NTOK * D * 4;
constexpr size_t WS_ACT = WS_YS + (size_t)2 * NTOK * D * 2;
constexpr size_t WS_MIX = WS_YS;
constexpr size_t WS_FFN_END = WS_ACT + (size_t)2 * NTOK * DEXP * 2;
constexpr size_t WS_XB = WS_ACT;
static_assert(WS_ACT >= WS_ATT_END, "XB must lie behind the attention-time view");
constexpr size_t WS_XB_END = WS_XB + (size_t)NTOK * D * 2;
constexpr size_t WS_END0 = WS_ATT_END > WS_FFN_END ? WS_ATT_END : WS_FFN_END;
constexpr size_t WS_END = WS_END0 > WS_XB_END ? WS_END0 : WS_XB_END;

constexpr int CW_ATTQ = 4096;
constexpr int CW_CONVQ = 4096 + 64 * 3 + 32;
constexpr int CW_CNT = 4352;
constexpr int CW_BASE = 8448;

constexpr int TILE_B = 256 * 64 * 2;
constexpr int STAGE_B = 2 * TILE_B;
constexpr int LDS_AUX = 150 * 1024;
constexpr int AUX_ROWSS = 0, AUX_FLAGS = 1024, AUX_SLOT = 1088, AUX_HIST = 1152, AUX_CNTS = 1536, AUX_MTS = 1792, AUX_RBS = 2048;
constexpr int LDS_BAR = LDS_AUX + 4096;
constexpr int LDS_BYTES = LDS_BAR + 16;
constexpr int NTHR = 512, NWAVE = 8;
extern __shared__ __attribute__((aligned(1024))) char smem[];

#define XB_TMO      128
#define XB_XCNT(j)  (256  + 64 * (j))
#define XB_XSUB(j)  (1280 + 64 * (j))
#define XB_XGEN(j)  (2304 + 64 * (j))
#define XB_TOP      3328
#define XB_TOPGEN   3392
#define XCD_BAR_WORDS 3456
#define XB_SPIN_CAP (1u << 20)
#define LAS __attribute__((address_space(3)))
DI unsigned xb_ld(unsigned* p)              { return __hip_atomic_load(p, __ATOMIC_RELAXED, __HIP_MEMORY_SCOPE_AGENT); }
DI unsigned xb_add(unsigned* p, unsigned v) { return __hip_atomic_fetch_add(p, v, __ATOMIC_RELAXED, __HIP_MEMORY_SCOPE_AGENT); }
DI unsigned xb_xcc_id() { return (unsigned)__builtin_amdgcn_s_getreg((3 << 11) | 20) & 0xFu; }
#define XB_SPIN(cond, bar) do { unsigned _sp = 0; while (cond) { __builtin_amdgcn_s_sleep(1); \
    if ((++_sp & 255u) == 0u) { if (xb_ld(&(bar)[XB_TMO])) break; if (_sp > XB_SPIN_CAP) { atomicAdd(&(bar)[XB_TMO], 1u); break; } } } } while (0)
struct XcdBarrier { unsigned* bar; unsigned x; volatile LAS unsigned* st; };
DI XcdBarrier xcd_barrier_post(unsigned* bar, volatile LAS unsigned* st) {
    XcdBarrier b; b.bar = bar; b.x = xb_xcc_id(); b.st = st;
    if (threadIdx.x == 0) (void)xb_add(&bar[XB_XCNT(b.x)], 1u);
    return b;
}
DI void xcd_barrier_complete(unsigned* bar, unsigned x, unsigned& nloc, unsigned& nx) {
    const unsigned G = gridDim.x * gridDim.y * gridDim.z;
    unsigned sum, cnt, mine, sp = 0u;
    for (;;) {
        sum = 0u; cnt = 0u; mine = 0u;
#pragma unroll
        for (unsigned j = 0; j < 16; ++j) { const unsigned c = xb_ld(&bar[XB_XCNT(j)]); sum += c; cnt += (c > 0u) ? 1u : 0u; mine = (j == x) ? c : mine; }
        if (sum == G) break;
        __builtin_amdgcn_s_sleep(1);
        if ((++sp & 255u) == 0u) { if (xb_ld(&bar[XB_TMO])) break; if (sp > XB_SPIN_CAP) { atomicAdd(&bar[XB_TMO], 1u); break; } }
    }
    nloc = mine > 0u ? mine : 1u; nx = cnt > 0u ? cnt : 1u;
}
DI void xcd_barrier(const XcdBarrier& b_) {
    XcdBarrier b; b.bar = b_.bar; b.x = xb_xcc_id(); b.st = (volatile LAS unsigned*)(smem + LDS_BAR);
    asm volatile("s_waitcnt vmcnt(0)" ::: "memory");
    __syncthreads();
    if (threadIdx.x == 0) {
        unsigned* bar = b.bar;
        __builtin_amdgcn_s_waitcnt(0);
        unsigned nloc = b.st[0], nx = b.st[1];
        if (nloc == 0u) { xcd_barrier_complete(bar, b.x, nloc, nx); b.st[0] = nloc; b.st[1] = nx; }
        const unsigned old = xb_add(&bar[XB_XSUB(b.x)], 1u);
        const unsigned gen = old / nloc;
        if (old + 1u == (gen + 1u) * nloc) {
            __builtin_amdgcn_fence(__ATOMIC_RELEASE, "agent");
            asm volatile("s_waitcnt vmcnt(0)" ::: "memory");
            const unsigned og = xb_add(&bar[XB_TOP], 1u);
            const unsigned tg = og / nx;
            if (og + 1u == (tg + 1u) * nx) xb_add(&bar[XB_TOPGEN], 1u);
            else XB_SPIN(xb_ld(&bar[XB_TOPGEN]) == tg, bar);
            __builtin_amdgcn_fence(__ATOMIC_ACQUIRE, "agent");
            xb_add(&bar[XB_XGEN(b.x)], 1u);
            asm volatile("s_waitcnt vmcnt(0)" ::: "memory");
        } else {
            XB_SPIN(xb_ld(&bar[XB_XGEN(b.x)]) == gen, bar);
            __builtin_amdgcn_fence(__ATOMIC_ACQUIRE, "agent");
            asm volatile("s_waitcnt vmcnt(0)" ::: "memory");
        }
    }
    __syncthreads();
}

DI float bf2f(unsigned v16) { return __uint_as_float(v16 << 16); }
DI unsigned cvtpk(float lo, float hi) { f32x2 v = {lo, hi}; bf16x2_t b = __builtin_convertvector(v, bf16x2_t); return __builtin_bit_cast(unsigned, b); }
DI int crow(int i, int h) { return (i & 3) + 8 * (i >> 2) + 4 * h; }
DI float dpp_add(float v, const int ctrl_tag) {
    int r;
    if (ctrl_tag == 0) r = __builtin_amdgcn_update_dpp(0, __float_as_int(v), 0xB1, 0xf, 0xf, true);
    else if (ctrl_tag == 1) r = __builtin_amdgcn_update_dpp(0, __float_as_int(v), 0x4E, 0xf, 0xf, true);
    else if (ctrl_tag == 2) r = __builtin_amdgcn_update_dpp(0, __float_as_int(v), 0x124, 0xf, 0xf, true);
    else r = __builtin_amdgcn_update_dpp(0, __float_as_int(v), 0x128, 0xf, 0xf, true);
    return v + __int_as_float(r);
}
DI float wsum(float v) {
    v = dpp_add(v, 0); v = dpp_add(v, 1); v = dpp_add(v, 2); v = dpp_add(v, 3);
    const int iv = __float_as_int(v);
    return (__int_as_float(__builtin_amdgcn_readlane(iv, 0)) + __int_as_float(__builtin_amdgcn_readlane(iv, 16))) +
           (__int_as_float(__builtin_amdgcn_readlane(iv, 32)) + __int_as_float(__builtin_amdgcn_readlane(iv, 48)));
}
DI float xhalf(float v) {
    const unsigned mine = __float_as_uint(v);
    auto rr = __builtin_amdgcn_permlane32_swap(mine, mine, false, false);
    const unsigned a = rr[0], b = rr[1];
    return __uint_as_float(a == mine ? b : a);
}
DI int xhalf_i(int v) {
    const unsigned mine = (unsigned)v;
    auto rr = __builtin_amdgcn_permlane32_swap(mine, mine, false, false);
    const unsigned a = rr[0], b = rr[1];
    return (int)(a == mine ? b : a);
}
DI int otid() { int t = threadIdx.x; asm volatile("" : "+v"(t)); return t; }
DI void st4bf(bf16_t* pz, float a, float b, float c, float d);
DI void st4bf(bf16_t* pz, const f32x4& v);
DI float fexp2(float x) { return __builtin_amdgcn_exp2f(x); }
DI float flog2(float x) { return __builtin_amdgcn_logf(x); }
DI float frcp(float x) { return __builtin_amdgcn_rcpf(x); }
DI float sigmoidf_(float x) { return frcp(1.0f + fexp2(-x * LOG2E)); }

struct Params {
    const float *x, *c; const int* pos;
    const float *ada_w, *ada_b, *w_in, *q_norm, *kv_norm, *w_uq, *w_ukv, *w_o, *ln1_g, *ln1_b, *router_w, *router_bias, *w_gate, *w_up, *w_down, *ln2_g, *ln2_b;
    float* out; unsigned char* ws;
};


DI int lds_byte(int r, int c) { const int st = (r >> 4) * 2 + (c >> 5), ob = (r & 15) * 64 + (c & 31) * 2; return st * 1024 + (ob ^ (((ob >> 9) & 1) << 5)); }
DI void stage_rc(int b, int& R, int& C) { const int st = b >> 10, sb = b & 1023, swz = sb ^ (((sb >> 9) & 1) << 5); R = (st >> 1) * 16 + swz / 64; C = (st & 1) * 32 + (swz % 64) / 2; }
#define MFMA16(a, b, c) __builtin_amdgcn_mfma_f32_16x16x32_bf16((a), (b), (c), 0, 0, 0)
typedef f32x4 acc_t[2][2][4][2];
constexpr int HTB = 128 * 64 * 2;

template <class U, class Get, class ARow, class BRow, class KF, class Epi>
DI void gemm_stream(const char* abase, const char* bbase, const Get& get, const ARow& arow, const BRow& brow, const KF& kf, const Epi& epi) {
    const int tid = otid(), lane = tid & 63, wid = __builtin_amdgcn_readfirstlane(tid >> 6), wr = wid >> 2, wc = wid & 3, fr = lane & 15, fq = lane >> 4;
    U cur, nxt;
    int r = 0;
    if (!get(0, cur)) return;
    unsigned ao2[2][2], bo2[2][2], a11[2];
    auto setptr = [&](const U& u) {
        const int t2 = otid();
#pragma unroll
        for (int i = 0; i < 2; ++i) {
            int R, C; stage_rc(t2 * 16 + i * 8192, R, C);
#pragma unroll
            for (int h = 0; h < 2; ++h) { ao2[h][i] = arow(u, h * 128 + R) + 2 * C; bo2[h][i] = brow(u, h * 128 + R) + 2 * C; }
        }
    };
    setptr(cur);
    a11[0] = ao2[1][0]; a11[1] = ao2[1][1];
    const int aoff = lds_byte(wr * 64 + fr, fq * 8), boff = lds_byte(wc * 32 + fr, fq * 8);
#define G8_SA(b, h) (((b) * 2 + (h)) * HTB)
#define G8_SB(b, h) ((4 + (b) * 2 + (h)) * HTB)
#define G8_STAGE(bufoff, base, o0, o1, kt) do { \
        __builtin_amdgcn_global_load_lds((const unsigned*)((base) + (o0) + (kt) * 128), (unsigned*)(smem + (bufoff) + wid * 1024), 16, 0, 0); \
        __builtin_amdgcn_global_load_lds((const unsigned*)((base) + (o1) + (kt) * 128), (unsigned*)(smem + (bufoff) + wid * 1024 + 8192), 16, 0, 0); } while (0)
#define G8_LDA(dst, b, h) do { _Pragma("unroll") for (int m = 0; m < 4; ++m) _Pragma("unroll") for (int k = 0; k < 2; ++k) dst[m][k] = *(const bf16x8*)(smem + G8_SA(b, h) + aoff + m * 2048 + k * 1024); } while (0)
#define G8_LDB(dst, b, h) do { _Pragma("unroll") for (int n = 0; n < 2; ++n) _Pragma("unroll") for (int k = 0; k < 2; ++k) dst[n][k] = *(const bf16x8*)(smem + G8_SB(b, h) + boff + n * 2048 + k * 1024); } while (0)
#define G8_MMA(ai, bj, At_, Bt_) do { __builtin_amdgcn_s_setprio(1); _Pragma("unroll") for (int m = 0; m < 4; ++m) _Pragma("unroll") for (int n = 0; n < 2; ++n) _Pragma("unroll") for (int k = 0; k < 2; ++k) \
        acc[ai][bj][m][n] = MFMA16(Bt_[n][k], At_[m][k], acc[ai][bj][m][n]); __builtin_amdgcn_s_setprio(0); } while (0)
#define G8_WAIT_V(n) asm volatile("s_waitcnt vmcnt(" #n ")" ::: "memory")
#define G8_WAIT_L(n) asm volatile("s_waitcnt lgkmcnt(" #n ")" ::: "memory")
#define G8_BAR __builtin_amdgcn_s_barrier()
#define G8_SCHED __builtin_amdgcn_sched_barrier(0)
    __syncthreads();
    G8_STAGE(G8_SB(0, 0), bbase, bo2[0][0], bo2[0][1], 0); G8_STAGE(G8_SA(0, 0), abase, ao2[0][0], ao2[0][1], 0);
    G8_STAGE(G8_SB(0, 1), bbase, bo2[1][0], bo2[1][1], 0); G8_STAGE(G8_SA(0, 1), abase, ao2[1][0], ao2[1][1], 0);
    if (wr == 1) G8_BAR;
    G8_WAIT_V(4); G8_BAR;
    G8_STAGE(G8_SB(1, 0), bbase, bo2[0][0], bo2[0][1], 1); G8_STAGE(G8_SA(1, 0), abase, ao2[0][0], ao2[0][1], 1); G8_STAGE(G8_SB(1, 1), bbase, bo2[1][0], bo2[1][1], 1);
    G8_WAIT_V(6); G8_BAR;
    for (;;) {
        const int KT = kf(cur) >> 6;
        const bool has_next = get(r + 1, nxt);
        acc_t acc;
#pragma unroll
        for (int a = 0; a < 2; ++a)
#pragma unroll
            for (int b = 0; b < 2; ++b)
#pragma unroll
                for (int m = 0; m < 4; ++m)
#pragma unroll
                    for (int n = 0; n < 2; ++n) acc[a][b][m][n] = (f32x4){0.f, 0.f, 0.f, 0.f};
        bf16x8 At[4][2], B0[2][2], B1[2][2];
#pragma unroll 1
        for (int t = 0; t < KT; t += 2) {
            const bool last = (t == KT - 2);
            if (last && has_next) setptr(nxt);
            const int kt1 = t + 1, kt2 = last ? 0 : t + 2, kt3 = kt2 + 1;
            G8_LDB(B0, 0, 0); G8_SCHED; G8_LDA(At, 0, 0); G8_STAGE(G8_SA(1, 1), abase, a11[0], a11[1], kt1);
            G8_WAIT_L(8); G8_BAR; G8_WAIT_L(0); G8_MMA(0, 0, At, B0); G8_BAR; G8_SCHED;
            G8_LDB(B1, 0, 1); G8_STAGE(G8_SB(0, 0), bbase, bo2[0][0], bo2[0][1], kt2);
            G8_BAR; G8_WAIT_L(0); G8_MMA(0, 1, At, B1); G8_BAR;
            G8_LDA(At, 0, 1); G8_STAGE(G8_SA(0, 0), abase, ao2[0][0], ao2[0][1], kt2);
            G8_BAR; G8_WAIT_L(0); G8_MMA(1, 0, At, B0); G8_BAR; G8_SCHED;
            G8_STAGE(G8_SB(0, 1), bbase, bo2[1][0], bo2[1][1], kt2);
            G8_WAIT_V(6); G8_BAR; G8_MMA(1, 1, At, B1); G8_BAR;
            G8_LDB(B0, 1, 0); G8_SCHED; G8_LDA(At, 1, 0); G8_STAGE(G8_SA(0, 1), abase, ao2[1][0], ao2[1][1], kt2);
            G8_WAIT_L(8); G8_BAR; G8_WAIT_L(0); G8_MMA(0, 0, At, B0); G8_BAR; G8_SCHED;
            G8_LDB(B1, 1, 1); G8_STAGE(G8_SB(1, 0), bbase, bo2[0][0], bo2[0][1], kt3);
            G8_BAR; G8_WAIT_L(0); G8_MMA(0, 1, At, B1); G8_BAR;
            G8_LDA(At, 1, 1); G8_STAGE(G8_SA(1, 0), abase, ao2[0][0], ao2[0][1], kt3);
            G8_BAR; G8_WAIT_L(0); G8_MMA(1, 0, At, B0); G8_BAR; G8_SCHED;
            G8_STAGE(G8_SB(1, 1), bbase, bo2[1][0], bo2[1][1], kt3);
            G8_WAIT_V(6); G8_BAR; G8_MMA(1, 1, At, B1); G8_BAR;
            a11[0] = ao2[1][0]; a11[1] = ao2[1][1];
        }
        epi(cur, acc, wr, wc, fr, fq);
        if (!has_next) break;
        cur = nxt; ++r;
    }
    G8_WAIT_V(0);
    if (wr == 0) G8_BAR;
    G8_BAR;
#undef G8_SA
#undef G8_SB
#undef G8_STAGE
#undef G8_LDA
#undef G8_LDB
#undef G8_MMA
#undef G8_WAIT_V
#undef G8_WAIT_L
#undef G8_BAR
#undef G8_SCHED
}

struct ConvJob { const float* src; const float* src2; const float* kscale; bf16_t* dst; int N, K, nvalid, mode, k0, n0p; };
constexpr int CV_PITCH = 516;
DI void conv_load(const ConvJob& J, int tid, f32x4 (&v)[8]) {
    const int kk = tid >> 3, np = J.n0p + (tid & 7) * 32;
    const float* s = J.src; int col;
    if (J.mode == 0) col = np < J.nvalid ? np : -1;
    else if (J.mode == 1) col = np < 512 ? ((np >> 6) * 128 + (np & 63)) : (((np - 512) >> 6) * 128 + 64 + (np & 63));
    else { col = (np >> 8) * 128 + (np & 127); s = ((np >> 7) & 1) ? J.src2 : J.src; }
    const float* rowp = s + (size_t)(J.k0 + kk) * J.N + col;
#pragma unroll
    for (int i = 0; i < 8; ++i) v[i] = (col >= 0) ? *(const f32x4*)(rowp + 4 * i) : (f32x4){0.f, 0.f, 0.f, 0.f};
}
DI void conv_store(const ConvJob& J, int tid, const f32x4 (&v)[8]) {
    const int kk = tid >> 3, ch = tid & 7;
    const float ks = J.kscale ? J.kscale[J.k0 + kk] : 1.0f;
    __syncthreads();
#pragma unroll
    for (int i = 0; i < 8; ++i) {
        *(unsigned*)(smem + kk * CV_PITCH + ch * 64 + i * 8) = cvtpk(v[i][0] * ks, v[i][1] * ks);
        *(unsigned*)(smem + kk * CV_PITCH + ch * 64 + i * 8 + 4) = cvtpk(v[i][2] * ks, v[i][3] * ks);
    }
    __syncthreads();
#pragma unroll
    for (int i = 0; i < 4; ++i) {
        const int c = tid + NTHR * i, n = c >> 3, kc = c & 7;
        unsigned short e[8];
#pragma unroll
        for (int q = 0; q < 8; ++q) e[q] = *(const unsigned short*)(smem + (kc * 8 + q) * CV_PITCH + n * 2);
        u32x4 w;
        w.x = e[0] | ((unsigned)e[1] << 16); w.y = e[2] | ((unsigned)e[3] << 16); w.z = e[4] | ((unsigned)e[5] << 16); w.w = e[6] | ((unsigned)e[7] << 16);
        *(u32x4*)(J.dst + (size_t)(J.n0p + n) * J.K + J.k0 + kc * 8) = w;
    }
}

constexpr int CT_IN = 16 * 8, CT_UQ = 4 * 3, CT_UKV = 2 * 4, CT_O = 16 * 4, CT_GU = 32 * 16 * 2, CT_D = 32 * 4 * 4, CT_R = 16;
constexpr int CC1 = CT_IN, CC2 = CC1 + CT_UQ, CC3 = CC2 + CT_UKV, CC4 = CC3 + CT_O, CC5 = CC4 + CT_GU, CC6 = CC5 + CT_D;
DI ConvJob conv_job(const Params& p, int l, int t) {
    unsigned char* ws = p.ws;
    ConvJob J;
    if (t < CC1) { const int r = t; J = {p.w_in + (size_t)l * D * INW, nullptr, nullptr, (bf16_t*)(ws + WS_BTIN) + (size_t)l * INWP * D, INW, D, INW, 0, (r & 15) * 64, (r >> 4) * 256}; }
    else if (t < CC2) { const int r = t - CC1; J = {p.w_uq + (size_t)l * 256 * 768, nullptr, p.q_norm + l * 256, (bf16_t*)(ws + WS_BTUQ) + (size_t)l * 768 * 256, 768, 256, 768, 0, (r & 3) * 64, (r >> 2) * 256}; }
    else if (t < CC3) { const int r = t - CC2; J = {p.w_ukv + (size_t)l * 128 * 1024, nullptr, p.kv_norm + l * 128, (bf16_t*)(ws + WS_BTUKV) + (size_t)l * 1024 * 128, 1024, 128, 1024, 0, (r & 1) * 64, (r >> 1) * 256}; }
    else if (t < CC4) { const int r = t - CC3; J = {p.w_o + (size_t)l * D * D, nullptr, nullptr, (bf16_t*)(ws + WS_BTO) + (size_t)l * D * D, D, D, D, 0, (r & 15) * 64, (r >> 4) * 256}; }
    else if (t < CC5) { const int u = t - CC4, le = l * NEXP + u / 32, r = u % 32; J = {p.w_gate + (size_t)le * D * DEXP, p.w_up + (size_t)le * D * DEXP, nullptr, (bf16_t*)(ws + WS_BTGU) + (size_t)le * 512 * D, DEXP, D, 512, 2, (r & 15) * 64, (r >> 4) * 256}; }
    else if (t < CC6) { const int u = t - CC5, le = l * NEXP + u / 16, r = u % 16; J = {p.w_down + (size_t)le * DEXP * D, nullptr, nullptr, (bf16_t*)(ws + WS_BTD) + (size_t)le * D * DEXP, D, DEXP, D, 0, (r & 3) * 64, (r >> 2) * 256}; }
    else { const int r = t - CC6; J = {p.router_w, nullptr, nullptr, (bf16_t*)(ws + WS_BTR), NEXP, D, NEXP, 0, r * 64, 0}; }
    return J;
}
DI void conv_run(const Params& p, int l, bool with_router, int first, int stride) {
    const int tid = otid();
    const int n = CC6 + (with_router ? CT_R : 0);
    __syncthreads();
    int it = first;
    if (it < n) {
        f32x4 cur[8], nxt[8];
        ConvJob J = conv_job(p, l, it);
        conv_load(J, tid, cur);
        for (;;) {
            const int itn = it + stride;
            ConvJob Jn = J;
            if (itn < n) { Jn = conv_job(p, l, itn); conv_load(Jn, tid, nxt); }
            conv_store(J, tid, cur);
            if (itn >= n) break;
#pragma unroll
            for (int i = 0; i < 8; ++i) cur[i] = nxt[i];
            J = Jn; it = itn;
        }
    }
    __syncthreads();
}

DI void conv_run_queue(const Params& p, int l, bool with_router, unsigned* head) {
    const int tid = otid();
    const int n = CC6 + (with_router ? CT_R : 0);
    int* slot = (int*)(smem + LDS_AUX + AUX_SLOT);
    auto fetch = [&]() { int v = 0; if (otid() == 0) v = (int)__hip_atomic_fetch_add(head, 1u, __ATOMIC_RELAXED, __HIP_MEMORY_SCOPE_AGENT); return v; };
    auto share = [&](int v) { __syncthreads(); if (otid() == 0) *slot = v; __syncthreads(); return *slot; };
    int it = share(fetch());
    if (it < n) {
        f32x4 cur[8], nxt[8];
        ConvJob J = conv_job(p, l, it);
        conv_load(J, tid, cur);
        for (;;) {
            const int itn = share(fetch());
            ConvJob Jn = J;
            if (itn < n) { Jn = conv_job(p, l, itn); conv_load(Jn, tid, nxt); }
            conv_store(J, tid, cur);
            if (itn >= n) break;
#pragma unroll
            for (int i = 0; i < 8; ++i) cur[i] = nxt[i];
            J = Jn; it = itn;
        }
    }
    __syncthreads();
}

DI void phase0(const Params& p) {
    unsigned char* ws = p.ws;
    const int tid = otid();
    constexpr int N_MOD = 2 * 96, N_CS = NTOK / NTHR;
    for (int it = blockIdx.x; it < N_MOD + N_CS; it += gridDim.x) {
        if (it < N_MOD) {
            const int l = it / 96, n0 = (it % 96) * 64;
            float* sc = (float*)smem;
            __syncthreads();
            for (int i = tid; i < NB * D; i += NTHR) { const float v = p.c[i]; sc[i] = v * sigmoidf_(v); }
            __syncthreads();
            const int n = tid & 63, kq = tid >> 6;
            float acc[16];
#pragma unroll
            for (int b = 0; b < 16; ++b) acc[b] = 0.f;
            const float* wp = p.ada_w + (size_t)l * D * 6144 + n0 + n;
#pragma unroll 2
            for (int k = kq * 128; k < kq * 128 + 128; k += 4) {
                const float w0 = wp[(size_t)k * 6144], w1 = wp[(size_t)(k + 1) * 6144], w2 = wp[(size_t)(k + 2) * 6144], w3 = wp[(size_t)(k + 3) * 6144];
#pragma unroll
                for (int b = 0; b < 16; ++b) { const f32x4 s4 = *(const f32x4*)(sc + b * D + k); acc[b] += (s4[0] * w0 + s4[1] * w1) + (s4[2] * w2 + s4[3] * w3); }
            }
            float* part = (float*)(smem + 65536);
#pragma unroll
            for (int b = 0; b < 16; ++b) part[(kq * 16 + b) * 64 + n] = acc[b];
            __syncthreads();
            for (int i = tid; i < 16 * 64; i += NTHR) {
                const int b = i >> 6, nn = i & 63;
                float v = 0.f;
#pragma unroll
                for (int q = 0; q < 8; ++q) v += part[(q * 16 + b) * 64 + nn];
                ((float*)(ws + WS_MOD))[((size_t)l * NB + b) * 6144 + n0 + nn] = v + p.ada_b[(size_t)l * 6144 + n0 + nn];
            }
        } else {
            const int t = (it - N_MOD) * NTHR + tid;
            const float posf = (float)p.pos[t];
            float* cs = (float*)(ws + WS_CS) + (size_t)t * 32;
#pragma unroll
            for (int i = 0; i < 16; ++i) {
                const float inv = (float)exp2(-(double)i * (13.287712379549449 / 16.0));
                const float ang = posf * inv;
                const double rev = (double)ang * 0.15915494309189535;
                const float fr = (float)(rev - rint(rev));
                cs[i] = __builtin_amdgcn_cosf(fr);
                cs[16 + i] = __builtin_amdgcn_sinf(fr);
            }
        }
    }
    conv_run_queue(p, 0, true, (unsigned*)(ws + WS_CTL) + CW_CONVQ);
}

constexpr int RPW = NTOK / (256 * NWAVE);
struct RowVec { f32x4 v[4]; };
struct RowRaw { u32x4 w[2]; };
DI f32x4 bf4(unsigned a, unsigned b) { return (f32x4){bf2f(a & 0xffffu), bf2f(a >> 16), bf2f(b & 0xffffu), bf2f(b >> 16)}; }
DI void ldvec(RowVec& r, const float* base, int lane) {
#pragma unroll
    for (int i = 0; i < 2; ++i) { r.v[2 * i] = *(const f32x4*)(base + 512 * i + 8 * lane); r.v[2 * i + 1] = *(const f32x4*)(base + 512 * i + 8 * lane + 4); }
}
DI void ldraw(RowRaw& r, const bf16_t* base, int lane) {
#pragma unroll
    for (int i = 0; i < 2; ++i) r.w[i] = *(const u32x4*)(base + 512 * i + 8 * lane);
}
DI void raw2vec(RowVec& r, const RowRaw& q) {
#pragma unroll
    for (int i = 0; i < 2; ++i) { r.v[2 * i] = bf4(q.w[i].x, q.w[i].y); r.v[2 * i + 1] = bf4(q.w[i].z, q.w[i].w); }
}
DI void stvec_bf(bf16_t* base, const f32x4 (&v)[4], int lane) {
#pragma unroll
    for (int i = 0; i < 2; ++i) {
        u32x4 w; w.x = cvtpk(v[2 * i][0], v[2 * i][1]); w.y = cvtpk(v[2 * i][2], v[2 * i][3]); w.z = cvtpk(v[2 * i + 1][0], v[2 * i + 1][1]); w.w = cvtpk(v[2 * i + 1][2], v[2 * i + 1][3]);
        *(u32x4*)(base + 512 * i + 8 * lane) = w;
    }
}
DI void stvec_f32(float* base, const f32x4 (&v)[4], int lane) {
#pragma unroll
    for (int i = 0; i < 2; ++i) { *(f32x4*)(base + 512 * i + 8 * lane) = v[2 * i]; *(f32x4*)(base + 512 * i + 8 * lane + 4) = v[2 * i + 1]; }
}
DI void row_stats2(const f32x4 (&a)[4], const f32x4 (&b)[4], float& mua, float& rsa, float& mub, float& rsb) {
    float sa = 0.f, sb = 0.f;
#pragma unroll
    for (int i = 0; i < 4; ++i) { sa += (a[i][0] + a[i][1]) + (a[i][2] + a[i][3]); sb += (b[i][0] + b[i][1]) + (b[i][2] + b[i][3]); }
    mua = wsum(sa) * (1.0f / D); mub = wsum(sb) * (1.0f / D);
    float qa = 0.f, qb = 0.f;
#pragma unroll
    for (int i = 0; i < 4; ++i)
#pragma unroll
        for (int j = 0; j < 4; ++j) { const float da = a[i][j] - mua, db = b[i][j] - mub; qa += da * da; qb += db * db; }
    rsa = __builtin_amdgcn_rsqf(wsum(qa) * (1.0f / D) + 1e-5f); rsb = __builtin_amdgcn_rsqf(wsum(qb) * (1.0f / D) + 1e-5f);
}
DI void lds_vec_fill(int slot, const float* src, int tid) { for (int i = tid; i < D / 4; i += NTHR) *(f32x4*)(smem + 4096 * slot + 16 * i) = *(const f32x4*)(src + 4 * i); }
DI f32x4 lv(int slot, int i, int lane) { return *(const f32x4*)(smem + 4096 * slot + (512 * (i >> 1) + 8 * lane + 4 * (i & 1)) * 4); }
DI void modulate_store2(const f32x4 (&a)[4], const f32x4 (&b)[4], int sl_shift, int sl_scale, bf16_t* ha, bf16_t* hb_, int lane) {
    float mua, rsa, mub, rsb; row_stats2(a, b, mua, rsa, mub, rsb);
    f32x4 oa[4], ob[4];
#pragma unroll
    for (int i = 0; i < 4; ++i) { const f32x4 sc = lv(sl_scale, i, lane) + 1.0f, sh = lv(sl_shift, i, lane); oa[i] = (a[i] - mua) * rsa * sc + sh; ob[i] = (b[i] - mub) * rsb * sc + sh; }
    stvec_bf(ha, oa, lane); stvec_bf(hb_, ob, lane);
}
DI void affine_lds(f32x4 (&v)[4], float mu, float rs, int sl_g, int sl_b, int lane) {
#pragma unroll
    for (int i = 0; i < 4; ++i) v[i] = (v[i] - mu) * rs * lv(sl_g, i, lane) + lv(sl_b, i, lane);
}
constexpr int LNROWS = NWAVE * RPW;

DI void phase_ln0(const Params& p) {
    const int tid_ = otid(), lane = tid_ & 63, wv = tid_ >> 6;
    const float* mod = (const float*)(p.ws + WS_MOD);
    bf16_t* hb = (bf16_t*)(p.ws + WS_HBUF);
    for (int rb = blockIdx.x * LNROWS; rb < NTOK; rb += gridDim.x * LNROWS) {
        const int b = rb / SEQ, r0 = rb + wv * RPW;
        __syncthreads();
        lds_vec_fill(0, mod + (size_t)b * 6144, tid_); lds_vec_fill(1, mod + (size_t)b * 6144 + 1024, tid_);
        __syncthreads();
        RowVec c0, c1;
        ldvec(c0, p.x + (size_t)r0 * D, lane); ldvec(c1, p.x + (size_t)(r0 + 1) * D, lane);
#pragma unroll 1
        for (int k = 0; k < RPW; k += 2) {
            const int row = r0 + k;
            f32x4 va[4], vb[4];
#pragma unroll
            for (int i = 0; i < 4; ++i) { va[i] = c0.v[i]; vb[i] = c1.v[i]; }
            if (k + 2 < RPW) { ldvec(c0, p.x + (size_t)(row + 2) * D, lane); ldvec(c1, p.x + (size_t)(row + 3) * D, lane); }
            modulate_store2(va, vb, 0, 1, hb + (size_t)row * D, hb + (size_t)(row + 1) * D, lane);
        }
    }
}

constexpr int RT_W = 20480, RT_PITCH = 2064, RT_STG = RT_W + 32 * RT_PITCH + 16;
static_assert(RT_STG + NWAVE * 4 * RT_PITCH <= LDS_AUX, "router staging must end below the aux region");
template <bool XBF>
DI void phase_ln1(const Params& p, int l) {
    const int tid_ = otid(), lane = tid_ & 63, wv = tid_ >> 6, fr = lane & 15, fq = lane >> 4;
    const float* mod = (const float*)(p.ws + WS_MOD) + (size_t)l * NB * 6144;
    bf16_t* x1 = (bf16_t*)(p.ws + WS_X1);
    const bf16_t* mix = (const bf16_t*)(p.ws + WS_MIX);
    const bf16_t* xb = (const bf16_t*)(p.ws + WS_XB);
    bf16_t* hb = (bf16_t*)(p.ws + WS_HBUF);
    const bf16_t* btr = (const bf16_t*)(p.ws + WS_BTR);
    const float* rbias = p.router_bias;
    unsigned* cnt = (unsigned*)(p.ws + WS_CTL) + CW_CNT + l * 2048;
    int* tes = (int*)(p.ws + WS_TOKES); float* tg = (float*)(p.ws + WS_TOKG); int* list = (int*)(p.ws + WS_LIST);
    unsigned* hist = (unsigned*)(smem + LDS_AUX + AUX_HIST);
    char* stg = smem + RT_STG + wv * (4 * RT_PITCH);
    struct In { RowVec x; RowRaw xr; RowRaw m; };
    __syncthreads();
    for (int i = tid_; i < 32 * 128; i += NTHR) { const int row = i >> 7, c = i & 127; *(u32x4*)(smem + RT_W + row * RT_PITCH + c * 16) = *(const u32x4*)(btr + (size_t)row * D + c * 8); }
    for (int rb = blockIdx.x * LNROWS; rb < NTOK; rb += gridDim.x * LNROWS) {
        const int b = rb / SEQ, r0 = rb + wv * RPW;
        __syncthreads();
        lds_vec_fill(0, p.ln1_g + l * D, tid_); lds_vec_fill(1, p.ln1_b + l * D, tid_);
        lds_vec_fill(2, mod + (size_t)b * 6144 + 2048, tid_); lds_vec_fill(3, mod + (size_t)b * 6144 + 3072, tid_); lds_vec_fill(4, mod + (size_t)b * 6144 + 4096, tid_);
        if (tid_ < 32) hist[tid_] = 0u;
        __syncthreads();
        auto ldrow = [&](int row, In& q) {
            if (XBF) ldraw(q.xr, xb + (size_t)row * D, lane); else ldvec(q.x, p.x + (size_t)row * D, lane);
            ldraw(q.m, mix + (size_t)row * D, lane);
        };
        auto form = [&](In& q, f32x4 (&v)[4]) {
            RowVec xv, mv; if (XBF) raw2vec(xv, q.xr); else xv = q.x; raw2vec(mv, q.m);
#pragma unroll
            for (int i = 0; i < 4; ++i) v[i] = xv.v[i] * ALPHA + (lv(2, i, lane) + 1.0f) * mv.v[i];
        };
        unsigned pk[RPW / 4]; float ga[RPW / 4];
        In c0, c1;
        ldrow(r0, c0); ldrow(r0 + 1, c1);
#pragma unroll
        for (int k = 0; k < RPW; k += 2) {
            const int row = r0 + k;
            f32x4 va[4], vb[4]; form(c0, va); form(c1, vb);
            if (k + 2 < RPW) { ldrow(row + 2, c0); ldrow(row + 3, c1); }
            float mua, rsa, mub, rsb; row_stats2(va, vb, mua, rsa, mub, rsb);
            affine_lds(va, mua, rsa, 0, 1, lane); affine_lds(vb, mub, rsb, 0, 1, lane);
            stvec_bf(x1 + (size_t)row * D, va, lane); stvec_bf(x1 + (size_t)(row + 1) * D, vb, lane);
            {
                float m2a, r2a, m2b, r2b; row_stats2(va, vb, m2a, r2a, m2b, r2b);
#pragma unroll
                for (int i = 0; i < 2; ++i) {
                    u32x4 wa, wb;
#pragma unroll
                    for (int h = 0; h < 2; ++h) {
                        const f32x4 sc = lv(4, 2 * i + h, lane) + 1.0f, sh = lv(3, 2 * i + h, lane);
                        const f32x4 oa = (va[2 * i + h] - m2a) * r2a * sc + sh, ob = (vb[2 * i + h] - m2b) * r2b * sc + sh;
                        if (h == 0) { wa.x = cvtpk(oa[0], oa[1]); wa.y = cvtpk(oa[2], oa[3]); wb.x = cvtpk(ob[0], ob[1]); wb.y = cvtpk(ob[2], ob[3]); }
                        else { wa.z = cvtpk(oa[0], oa[1]); wa.w = cvtpk(oa[2], oa[3]); wb.z = cvtpk(ob[0], ob[1]); wb.w = cvtpk(ob[2], ob[3]); }
                    }
                    *(u32x4*)(hb + (size_t)row * D + 512 * i + 8 * lane) = wa; *(u32x4*)(hb + (size_t)(row + 1) * D + 512 * i + 8 * lane) = wb;
                    *(u32x4*)(stg + (k & 2) * RT_PITCH + (512 * i + 8 * lane) * 2) = wa; *(u32x4*)(stg + ((k & 2) + 1) * RT_PITCH + (512 * i + 8 * lane) * 2) = wb;
                }
            }
            if ((k & 2) == 0) continue;
            f32x4 acc[2] = {(f32x4){0.f, 0.f, 0.f, 0.f}, (f32x4){0.f, 0.f, 0.f, 0.f}};
            const bool arow_ok = fr < 4;
            const char* ap = stg + (fr & 3) * RT_PITCH + fq * 16;
            const char* bp = smem + RT_W + fr * RT_PITCH + fq * 16;
#pragma unroll 8
            for (int ks = 0; ks < 32; ++ks) {
                u32x4 aw = *(const u32x4*)(ap + ks * 64);
                if (!arow_ok) aw = (u32x4){0u, 0u, 0u, 0u};
                const bf16x8 af = __builtin_bit_cast(bf16x8, aw);
                const bf16x8 b0 = *(const bf16x8*)(bp + ks * 64), b1 = *(const bf16x8*)(bp + 16 * RT_PITCH + ks * 64);
                acc[0] = MFMA16(b0, af, acc[0]); acc[1] = MFMA16(b1, af, acc[1]);
            }
            {
                float sc[8], bs[8];
#pragma unroll
                for (int i = 0; i < 8; ++i) { sc[i] = sigmoidf_(acc[i >> 2][i & 3]); bs[i] = sc[i] + rbias[(i >> 2) * 16 + 4 * fq + (i & 3)]; }
                float gsv[2];
#pragma unroll
                for (int g = 0; g < 2; ++g) {
                    const float a_ = bs[4 * g], b_ = bs[4 * g + 1], c_ = bs[4 * g + 2], d_ = bs[4 * g + 3];
                    const float h1 = fmaxf(a_, b_), l1 = fminf(a_, b_), h2 = fmaxf(c_, d_), l2 = fminf(c_, d_);
                    gsv[g] = fmaxf(h1, h2) + fmaxf(fminf(h1, h2), fmaxf(l1, l2));
                }
                float best = gsv[0]; int bg = fq;
                if (gsv[1] > gsv[0]) { best = gsv[1]; bg = 4 + fq; }
#pragma unroll
                for (int off = 16; off <= 32; off <<= 1) {
                    const float ob = __shfl_xor(best, off); const int og = __shfl_xor(bg, off);
                    if (ob > best || (ob == best && og < bg)) { best = ob; bg = og; }
                }
                pk[k >> 2] = 0u; ga[k >> 2] = 0.f;
                if (arow_ok && (bg & 3) == fq) {
                    const bool up = bg >= 4;
                    float s4[4], b4[4];
#pragma unroll
                    for (int jj = 0; jj < 4; ++jj) { s4[jj] = up ? sc[4 + jj] : sc[jj]; b4[jj] = up ? bs[4 + jj] : bs[jj]; }
                    int i0 = 0; float v0 = b4[0];
#pragma unroll
                    for (int jj = 1; jj < 4; ++jj) if (b4[jj] > v0) { v0 = b4[jj]; i0 = jj; }
                    int i1 = 0; float v1 = -1e30f;
#pragma unroll
                    for (int jj = 0; jj < 4; ++jj) if (jj != i0 && b4[jj] > v1) { v1 = b4[jj]; i1 = jj; }
                    const float sa = i0 == 0 ? s4[0] : i0 == 1 ? s4[1] : i0 == 2 ? s4[2] : s4[3];
                    const float sb = i1 == 0 ? s4[0] : i1 == 1 ? s4[1] : i1 == 2 ? s4[2] : s4[3];
                    ga[k >> 2] = sa / (sa + sb);
                    const unsigned e0 = 4 * bg + i0, e1 = 4 * bg + i1;
                    const unsigned ls0 = atomicAdd(&hist[e0], 1u), ls1 = atomicAdd(&hist[e1], 1u);
                    pk[k >> 2] = e0 | (e1 << 5) | (ls0 << 10) | (ls1 << 19) | (1u << 28);
                }
            }
        }
        __syncthreads();
        if (tid_ < 32) hist[32 + tid_] = atomicAdd(&cnt[64 * tid_], hist[tid_]);
        __syncthreads();
#pragma unroll
        for (int q = 0; q < RPW / 4; ++q) {
            if (pk[q] >> 28) {
                const int tok = r0 + 4 * q + fr;
                const int e0 = pk[q] & 31, e1 = (pk[q] >> 5) & 31;
                const int s0 = (int)hist[32 + e0] + (int)((pk[q] >> 10) & 511), s1 = (int)hist[32 + e1] + (int)((pk[q] >> 19) & 511);
                tes[tok * 2] = (e0 << 24) | s0; tes[tok * 2 + 1] = (e1 << 24) | s1;
                tg[tok * 2] = ga[q]; tg[tok * 2 + 1] = 1.0f - ga[q];
                list[(size_t)e0 * NTOK + s0] = tok; list[(size_t)e1 * NTOK + s1] = tok;
            }
        }
    }
    __syncthreads();
}

DI void phase_ln2(const Params& p, int l, float* xout) {
    const int tid_ = otid(), lane = tid_ & 63, wv = tid_ >> 6;
    const float* mod = (const float*)(p.ws + WS_MOD) + (size_t)l * NB * 6144;
    const bf16_t* x1 = (const bf16_t*)(p.ws + WS_X1);
    bf16_t* xb = (bf16_t*)(p.ws + WS_XB);
    const bf16_t* ys = (const bf16_t*)(p.ws + WS_YS);
    const int* tes = (const int*)(p.ws + WS_TOKES);
    const float* tg = (const float*)(p.ws + WS_TOKG);
    const unsigned* ebase = (const unsigned*)(p.ws + WS_CTL) + CW_BASE + l * 64;
    bf16_t* hb = (bf16_t*)(p.ws + WS_HBUF);
    const float* modn = (const float*)(p.ws + WS_MOD) + (size_t)(l + 1 < DEPTH ? l + 1 : l) * NB * 6144;
    struct In { RowRaw x, y0, y1; };
    for (int rb = blockIdx.x * LNROWS; rb < NTOK; rb += gridDim.x * LNROWS) {
        const int b = rb / SEQ, r0 = rb + wv * RPW;
        __syncthreads();
        lds_vec_fill(0, p.ln2_g + l * D, tid_); lds_vec_fill(1, p.ln2_b + l * D, tid_);
        lds_vec_fill(2, mod + (size_t)b * 6144 + 5120, tid_); lds_vec_fill(3, modn + (size_t)b * 6144, tid_); lds_vec_fill(4, modn + (size_t)b * 6144 + 1024, tid_);
        __syncthreads();
        int es = 0; float gv = 0.f;
        if (lane < 2 * RPW) { es = tes[(size_t)r0 * 2 + lane]; gv = tg[(size_t)r0 * 2 + lane]; es = (int)(ebase[es >> 24] + (unsigned)(es & 0xffffff)); }
        auto ldrow = [&](int k, In& q) {
            const size_t p0 = (size_t)__shfl(es, 2 * k), p1 = (size_t)__shfl(es, 2 * k + 1);
            ldraw(q.x, x1 + (size_t)(r0 + k) * D, lane); ldraw(q.y0, ys + p0 * D, lane); ldraw(q.y1, ys + p1 * D, lane);
        };
        auto form = [&](int k, const In& q, f32x4 (&v)[4]) {
            const float g0 = __shfl(gv, 2 * k), g1 = __shfl(gv, 2 * k + 1);
            RowVec xv, a0, a1; raw2vec(xv, q.x); raw2vec(a0, q.y0); raw2vec(a1, q.y1);
#pragma unroll
            for (int i = 0; i < 4; ++i) v[i] = xv.v[i] * ALPHA + (lv(2, i, lane) + 1.0f) * (a0.v[i] * g0 + a1.v[i] * g1);
        };
        In c0, c1;
        ldrow(0, c0); ldrow(1, c1);
#pragma unroll 1
        for (int k = 0; k < RPW; k += 2) {
            const int row = r0 + k;
            f32x4 va[4], vb[4]; form(k, c0, va); form(k + 1, c1, vb);
            if (k + 2 < RPW) { ldrow(k + 2, c0); ldrow(k + 3, c1); }
            float mua, rsa, mub, rsb; row_stats2(va, vb, mua, rsa, mub, rsb);
            affine_lds(va, mua, rsa, 0, 1, lane); affine_lds(vb, mub, rsb, 0, 1, lane);
            if (l + 1 < DEPTH) {
                stvec_bf(xb + (size_t)row * D, va, lane); stvec_bf(xb + (size_t)(row + 1) * D, vb, lane);
                modulate_store2(va, vb, 3, 4, hb + (size_t)row * D, hb + (size_t)(row + 1) * D, lane);
            } else {
                stvec_f32(xout + (size_t)row * D, va, lane); stvec_f32(xout + (size_t)(row + 1) * D, vb, lane);
            }
        }
    }
}

DI int unit_id(int r) {
    const int g8 = gridDim.x >> 3;
    if ((gridDim.x & 7) != 0) return r * gridDim.x + blockIdx.x;
    return (r * 8 + (blockIdx.x & 7)) * g8 + (blockIdx.x >> 3);
}
DI void st4bf(bf16_t* pz, float a, float b, float c, float d) { u32x2 w; w.x = cvtpk(a, b); w.y = cvtpk(c, d); *(u32x2*)pz = w; }
DI void st4bf(bf16_t* pz, const f32x4& v) { st4bf(pz, v[0], v[1], v[2], v[3]); }
DI int prow(int R) { const int q = R & 31; return (R & ~31) | (8 * ((q & 15) >> 2) + 4 * (q >> 4) + (q & 3)); }
DI int erow(int ai, int wr, int m, int fr) { return ai * 128 + wr * 64 + m * 16 + fr; }
DI int ecol(int bj, int wc, int fq) { return bj * 128 + wc * 32 + 8 * fq; }
DI void st8bf(bf16_t* pz, const f32x4& a, const f32x4& b) { u32x4 w; w.x = cvtpk(a[0], a[1]); w.y = cvtpk(a[2], a[3]); w.z = cvtpk(b[0], b[1]); w.w = cvtpk(b[2], b[3]); *(u32x4*)pz = w; }

constexpr int SL_STAGE = 49152, SL_B = 16384;
template <int MB, int NQ, class ARow, class BRow, class Conv, class Dst>
DI void gemm_slice(const char* abase, const char* bbase, const int KT, const ARow& arow, const BRow& brow, const Conv& conv, const Dst& dst) {
    const int tid = otid(), lane = tid & 63, wid = __builtin_amdgcn_readfirstlane(tid >> 6), wr = wid >> 2, wc = wid & 3, fr = lane & 15, fq = lane >> 4;
    constexpr int NA = MB / 2;
    unsigned ao[NA], bo[4];
#pragma unroll
    for (int i = 0; i < 4; ++i) { int R, C; stage_rc(wid * 1024 + i * 8192 + lane * 16, R, C); bo[i] = brow(R) + 2 * C; if (i < NA) ao[i] = arow(R) + 2 * C; }
#define SL_STAGE_IN(s, kt) do { _Pragma("unroll") for (int i = 0; i < 4; ++i) { \
        if (i < NA) __builtin_amdgcn_global_load_lds((const unsigned*)(abase + ao[i < NA ? i : 0] + (kt) * 128), (unsigned*)(smem + (s) * SL_STAGE + wid * 1024 + i * 8192), 16, 0, 0); \
        __builtin_amdgcn_global_load_lds((const unsigned*)(bbase + bo[i] + (kt) * 128), (unsigned*)(smem + (s) * SL_STAGE + SL_B + wid * 1024 + i * 8192), 16, 0, 0); } } while (0)
    f32x4 acc[MB][4];
#pragma unroll
    for (int m = 0; m < MB; ++m)
#pragma unroll
        for (int n = 0; n < 4; ++n) acc[m][n] = (f32x4){0.f, 0.f, 0.f, 0.f};
    __syncthreads();
    SL_STAGE_IN(0, 0);
    if (KT > 1) SL_STAGE_IN(1, 1);
    int cs = 0;
#pragma unroll 1
    for (int t = 0; t < KT; ++t) {
        if (t + 1 < KT) { if (NA == 1) asm volatile("s_waitcnt vmcnt(5)" ::: "memory"); else asm volatile("s_waitcnt vmcnt(6)" ::: "memory"); }
        else asm volatile("s_waitcnt vmcnt(0)" ::: "memory");
        __syncthreads();
        const int ns = cs == 0 ? 2 : cs - 1;
        if (t + 2 < KT) SL_STAGE_IN(ns, t + 2);
        const char* sa = smem + cs * SL_STAGE; const char* sb = sa + SL_B;
        bf16x8 At[2][MB], Bf[2][4];
#pragma unroll
        for (int ks = 0; ks < 2; ++ks) {
#pragma unroll
            for (int n = 0; n < 4; ++n) Bf[ks][n] = *(const bf16x8*)(sb + lds_byte(wc * 64 + n * 16 + fr, ks * 32 + fq * 8));
#pragma unroll
            for (int m = 0; m < MB; ++m) At[ks][m] = *(const bf16x8*)(sa + lds_byte(wr * (16 * MB) + m * 16 + fr, ks * 32 + fq * 8));
        }
#pragma unroll
        for (int ks = 0; ks < 2; ++ks)
#pragma unroll
            for (int m = 0; m < MB; ++m)
#pragma unroll
                for (int n = 0; n < 4; ++n) acc[m][n] = MFMA16(Bf[ks][n], At[ks][m], acc[m][n]);
        cs = cs == 2 ? 0 : cs + 1;
    }
#undef SL_STAGE_IN
    __syncthreads();
    constexpr int CPRW = 16 * NQ, R = 32 * MB;
    char* F = smem;
#pragma unroll
    for (int m = 0; m < MB; ++m)
#pragma unroll
        for (int q = 0; q < NQ; ++q) {
            f32x4 a, b; conv(acc, m, q, a, b);
            const int row = wr * (16 * MB) + m * 16 + fr, c16 = wc * (4 * NQ) + q * 4 + fq;
            u32x4 w; w.x = cvtpk(a[0], a[1]); w.y = cvtpk(a[2], a[3]); w.z = cvtpk(b[0], b[1]); w.w = cvtpk(b[2], b[3]);
            *(u32x4*)(F + row * (CPRW * 16) + ((c16 ^ (row & (CPRW - 1))) * 16)) = w;
        }
    __syncthreads();
    {
        const int t = otid(), c16 = t & (CPRW - 1), r0 = t / CPRW;
#pragma unroll
        for (int k = 0; k < R * CPRW / NTHR; ++k) {
            const int row = r0 + k * (NTHR / CPRW);
            bf16_t* d = dst(row, c16);
            const u32x4 w = *(const u32x4*)(F + row * (CPRW * 16) + ((c16 ^ (row & (CPRW - 1))) * 16));
            if (d) *(u32x4*)d = w;
        }
    }
    __syncthreads();
}

struct UG1 { int m0, nt; };
DI void phase_gemm1(const Params& p, int l) {
    unsigned char* ws = p.ws;
    const bf16_t* hb = (const bf16_t*)(ws + WS_HBUF);
    const bf16_t* bt = (const bf16_t*)(ws + WS_BTIN) + (size_t)l * INWP * D;
    bf16_t* sbq = (bf16_t*)(ws + WS_SBQ); bf16_t* lat = (bf16_t*)(ws + WS_LAT);
    static_assert(WS_SBK == WS_SBQ + (size_t)NTOK * 1024 && WS_SBV == WS_SBK + (size_t)NTOK * 1024, "sbq|sbk|sbv must be consecutive");
    float* ssl = (float*)(ws + WS_SS) + (size_t)l * 2 * NTOK;
    const float* cs = (const float*)(ws + WS_CS);
    constexpr int NTL = (NTOK / 256) * 8;
    auto get = [=](int r, UG1& u) { const int t = unit_id(r); if (t >= NTL) return false; u.m0 = (t >> 3) * 256; u.nt = (t + r) & 7; return true; };
    auto arow = [=](const UG1& u, int r) { return (unsigned)(u.m0 + r) * (D * 2u); };
    auto brow = [=](const UG1& u, int r) { return (unsigned)(u.nt * 256 + prow(r)) * (D * 2u); };
    auto kf = [=](const UG1&) { return D; };
    auto epi = [=](const UG1& u, const acc_t& acc, int wr, int wc, int fr, int fq) {
        const int m0 = u.m0, nt = u.nt, n0 = nt * 256;
        if (nt < 6) {
            const float sc = nt < 2 ? 0.125f * LOG2E : 1.0f;
            bf16_t* dstb = sbq + (size_t)(nt >> 1) * ((size_t)NTOK * 512) + (n0 & 511);
#pragma unroll
            for (int ai = 0; ai < 2; ++ai)
#pragma unroll
                for (int m = 0; m < 4; ++m) {
                    bf16_t* rp = dstb + (size_t)(m0 + erow(ai, wr, m, fr)) * 512;
#pragma unroll
                    for (int bj = 0; bj < 2; ++bj) st8bf(rp + ecol(bj, wc, fq), acc[ai][bj][m][0] * sc, acc[ai][bj][m][1] * sc);
                }
        } else {
            const bool ropew = nt == 7 && wc == 0;
            const int ci = (8 * fq) & 15;
#pragma unroll
            for (int ai = 0; ai < 2; ++ai)
#pragma unroll
                for (int m = 0; m < 4; ++m) {
                    const int trow = m0 + erow(ai, wr, m, fr);
                    float ssq = 0.f;
#pragma unroll
                    for (int bj = 0; bj < 2; ++bj) {
                        const f32x4 a0 = acc[ai][bj][m][0], a1 = acc[ai][bj][m][1];
                        if (nt == 6 || bj == 0) ssq += ((a0[0] * a0[0] + a0[1] * a0[1]) + (a0[2] * a0[2] + a0[3] * a0[3])) + ((a1[0] * a1[0] + a1[1] * a1[1]) + (a1[2] * a1[2] + a1[3] * a1[3]));
                    }
                    ssq += __shfl_xor(ssq, 16); ssq += __shfl_xor(ssq, 32);
                    if (fq == 0) atomicAdd(&ssl[(size_t)(nt - 6) * NTOK + trow], ssq);
                    bf16_t* rp = lat + (size_t)trow * LATW + (n0 - 1536);
                    st8bf(rp + ecol(0, wc, fq), acc[ai][0][m][0], acc[ai][0][m][1]);
                    if (nt == 6) st8bf(rp + ecol(1, wc, fq), acc[ai][1][m][0], acc[ai][1][m][1]);
                    else if (ropew) {
                        f32x4 a = acc[ai][1][m][0], b = acc[ai][1][m][1];
                        const float* c = cs + (size_t)trow * 32;
                        const f32x4 c0 = *(const f32x4*)(c + ci), c1 = *(const f32x4*)(c + ci + 4), s0 = *(const f32x4*)(c + 16 + ci), s1 = *(const f32x4*)(c + 16 + ci + 4);
                        f32x4 pa, pb;
#pragma unroll
                        for (int i = 0; i < 4; ++i) { pa[i] = xhalf(a[i]); pb[i] = xhalf(b[i]); }
                        if (fq < 2) { a = a * c0 - pa * s0; b = b * c1 - pb * s1; }
                        else        { a = pa * s0 + a * c0; b = pb * s1 + b * c1; }
                        st8bf(rp + ecol(1, wc, fq), a, b);
                    }
                }
        }
    };
    gemm_stream<UG1>((const char*)hb, (const char*)bt, get, arow, brow, kf, epi);
}

struct UG3 { int m0, j; };
DI void phase_mlaprep(const Params& p, int l) {
    unsigned char* ws = p.ws;
    const bf16_t* lat = (const bf16_t*)(ws + WS_LAT);
    const bf16_t* btq = (const bf16_t*)(ws + WS_BTUQ) + (size_t)l * 768 * 256;
    const bf16_t* btkv = (const bf16_t*)(ws + WS_BTUKV) + (size_t)l * 1024 * 128;
    bf16_t* qm = (bf16_t*)(ws + WS_QM); bf16_t* km = (bf16_t*)(ws + WS_KM);
    const float* cs = (const float*)(ws + WS_CS);
    const float* ss_q = (const float*)(ws + WS_SS) + (size_t)l * 2 * NTOK; const float* ss_kv = ss_q + NTOK;
    constexpr int NTL = (NTOK / 256) * 7;
    auto get = [=](int r, UG3& u) { const int t = unit_id(r); if (t >= NTL) return false; u.m0 = (t / 7) * 256; u.j = t % 7; return true; };
    const unsigned kvoff = (unsigned)((const char*)btkv - (const char*)btq);
    auto arow = [=](const UG3& u, int r) { return (unsigned)(u.m0 + r) * (LATW * 2u) + (u.j < 3 ? 0u : 512u); };
    auto brow = [=](const UG3& u, int r) { return u.j < 3 ? (unsigned)(u.j * 256 + prow(r)) * 512u : kvoff + (unsigned)((u.j - 3) * 256 + prow(r)) * 256u; };
    auto kf = [=](const UG3& u) { return u.j < 3 ? 256 : 128; };
    auto epi = [=](const UG3& u, const acc_t& acc, int wr, int wc, int fr, int fq) {
        const int m0 = u.m0, j = u.j;
        const float* ssp = j < 3 ? ss_q : ss_kv;
        const float qs = j < 3 ? 0.10206207261596575f * LOG2E : 1.0f;
        const float inw = j < 3 ? 1.0f / 256.0f : 1.0f / 128.0f;
        bf16_t* dbase = j < 3 ? qm + j * 256 : km + (j - 3) * 256;
        const int dpitch = j < 3 ? 768 : 1024;
#pragma unroll
        for (int ai = 0; ai < 2; ++ai)
#pragma unroll
            for (int m = 0; m < 4; ++m) {
                const int trow = m0 + erow(ai, wr, m, fr);
                const float rs = __builtin_amdgcn_rsqf(ssp[trow] * inw + 1e-6f) * qs;
                bf16_t* rp = dbase + (size_t)trow * dpitch;
#pragma unroll
                for (int bj = 0; bj < 2; ++bj) st8bf(rp + ecol(bj, wc, fq), acc[ai][bj][m][0] * rs, acc[ai][bj][m][1] * rs);
            }
    };
    gemm_stream<UG3>((const char*)lat, (const char*)btq, get, arow, brow, kf, epi);
}

struct UG5 { int m0, n0; };
DI void phase_wo(const Params& p, int l) {
    unsigned char* ws = p.ws;
    const bf16_t* mg = (const bf16_t*)(ws + WS_HBUF);
    const bf16_t* bt = (const bf16_t*)(ws + WS_BTO) + (size_t)l * D * D;
    bf16_t* mix = (bf16_t*)(ws + WS_MIX);
    constexpr int NTL = (NTOK / 256) * 4;
    auto get = [=](int r, UG5& u) { const int t = unit_id(r); if (t >= NTL) return false; u.m0 = (t >> 2) * 256; u.n0 = (t & 3) * 256; return true; };
    auto arow = [=](const UG5& u, int r) { return (unsigned)(u.m0 + r) * (D * 2u); };
    auto brow = [=](const UG5& u, int r) { return (unsigned)(u.n0 + prow(r)) * (D * 2u); };
    auto kf = [=](const UG5&) { return D; };
    auto epi = [=](const UG5& u, const acc_t& acc, int wr, int wc, int fr, int fq) {
#pragma unroll
        for (int ai = 0; ai < 2; ++ai)
#pragma unroll
            for (int m = 0; m < 4; ++m) {
                bf16_t* rp = mix + (size_t)(u.m0 + erow(ai, wr, m, fr)) * D + u.n0;
#pragma unroll
                for (int bj = 0; bj < 2; ++bj) st8bf(rp + ecol(bj, wc, fq), acc[ai][bj][m][0], acc[ai][bj][m][1]);
            }
    };
    gemm_stream<UG5>((const char*)mg, (const char*)bt, get, arow, brow, kf, epi);
}

DI void moe_sched(const Params& p, int l) {
    const unsigned* cnt = (const unsigned*)(p.ws + WS_CTL) + CW_CNT + l * 2048;
    int* cnts = (int*)(smem + LDS_AUX + AUX_CNTS); int* mts = (int*)(smem + LDS_AUX + AUX_MTS); int* rbs = (int*)(smem + LDS_AUX + AUX_RBS);
    __syncthreads();
    if (otid() < 32) cnts[otid()] = (int)cnt[64 * otid()];
    __syncthreads();
    if (otid() == 0) {
        int a = 0, b = 0;
        for (int e = 0; e < 32; ++e) { mts[e] = a; rbs[e] = b; a += (cnts[e] + 255) >> 8; b += cnts[e]; }
        mts[32] = a; rbs[32] = b;
    }
    __syncthreads();
}
struct UGM { int e, mt, nt, ce, rb; };
DI bool moe_unit(int u, int nsh, UGM& o) {
    const int* cnts = (const int*)(smem + LDS_AUX + AUX_CNTS); const int* mts = (const int*)(smem + LDS_AUX + AUX_MTS); const int* rbs = (const int*)(smem + LDS_AUX + AUX_RBS);
    if (u >= (mts[32] << nsh)) return false;
    const int mtg = u >> nsh; int e = 0;
    for (int i = 1; i < 32; ++i) if (mts[i] <= mtg) e = i;
    o.e = e; o.mt = mtg - mts[e]; o.nt = u & ((1 << nsh) - 1); o.ce = cnts[e]; o.rb = rbs[e];
    return true;
}

DI void phase_moe1(const Params& p, int l) {
    unsigned char* ws = p.ws;
    moe_sched(p, l);
    const int* rbs = (const int*)(smem + LDS_AUX + AUX_RBS);
    if (blockIdx.x == 0 && otid() < 32) ((unsigned*)(ws + WS_CTL))[CW_BASE + l * 64 + otid()] = (unsigned)rbs[otid()];
    const bf16_t* hb = (const bf16_t*)(ws + WS_HBUF);
    const int* list = (const int*)(ws + WS_LIST);
    bf16_t* act = (bf16_t*)(ws + WS_ACT);
    const bf16_t* btl = (const bf16_t*)(ws + WS_BTGU) + (size_t)l * NEXP * 512 * D;
    const int G = gridDim.x, total = ((const int*)(smem + LDS_AUX + AUX_MTS))[32] * 2;
    const int full = total / G, n3 = total - full * G;
    const bool split = l + 1 == DEPTH && n3 > 0 && 4 * n3 <= G;
    auto get = [=](int r, UGM& u) { if (split && r >= full) return false; return moe_unit(unit_id(r), 1, u); };
    auto arow = [=](const UGM& u, int r) { int s = u.mt * 256 + r; s = s < u.ce ? s : u.ce - 1; return (unsigned)list[(size_t)u.e * NTOK + s] * (D * 2u); };
    auto brow = [=](const UGM& u, int r) { return (unsigned)(u.e * 512 + u.nt * 256 + prow(r)) * (D * 2u); };
    auto kf = [=](const UGM&) { return D; };
    auto epi = [=](const UGM& u, const acc_t& acc, int wr, int wc, int fr, int fq) {
#pragma unroll
        for (int ai = 0; ai < 2; ++ai)
#pragma unroll
            for (int m = 0; m < 4; ++m) {
                const int s = u.mt * 256 + erow(ai, wr, m, fr);
                f32x4 a, b;
#pragma unroll
                for (int jj = 0; jj < 4; ++jj) { const float g0 = acc[ai][0][m][0][jj], u0 = acc[ai][1][m][0][jj], g1 = acc[ai][0][m][1][jj], u1 = acc[ai][1][m][1][jj]; a[jj] = g0 * sigmoidf_(g0) * u0; b[jj] = g1 * sigmoidf_(g1) * u1; }
                if (s < u.ce) st8bf(act + (size_t)(u.rb + s) * DEXP + u.nt * 128 + wc * 32 + 8 * fq, a, b);
            }
    };
    gemm_stream<UGM>((const char*)hb, (const char*)btl, get, arow, brow, kf, epi);
    if (split) {
        const int v = unit_id(0);
        UGM u;
        if (v < 4 * n3 && moe_unit(full * G + (v >> 2), 1, u)) {
            const int sr = u.mt * 256 + (v & 3) * 64;
            if (sr < u.ce)
                gemm_slice<2, 1>((const char*)hb, (const char*)btl, D / 64,
                    [=](int r) { int s = sr + r; s = s < u.ce ? s : u.ce - 1; return (unsigned)list[(size_t)u.e * NTOK + s] * (D * 2u); },
                    [=](int r) { const int x = prow(r); return (unsigned)(u.e * 512 + u.nt * 256 + ((x >> 5) & 1) * 128 + ((x >> 6) & 3) * 32 + (x & 31)) * (D * 2u); },
                    [=](const f32x4 (&acc)[2][4], int m, int, f32x4& a, f32x4& b) {
#pragma unroll
                        for (int jj = 0; jj < 4; ++jj) { const float g0 = acc[m][0][jj], u0 = acc[m][2][jj], g1 = acc[m][1][jj], u1 = acc[m][3][jj]; a[jj] = g0 * sigmoidf_(g0) * u0; b[jj] = g1 * sigmoidf_(g1) * u1; }
                    },
                    [=](int row, int c16) { const int s = sr + row; return s < u.ce ? act + (size_t)(u.rb + s) * DEXP + u.nt * 128 + c16 * 8 : (bf16_t*)nullptr; });
        }
    }
    if (l + 1 < DEPTH) {
        const int v = unit_id(0);
        int first, stride;
        if (n3 == 0) { first = v; stride = G; } else { first = v - n3; stride = G - n3; }
        if (first >= 0) conv_run(p, l + 1, false, first, stride);
    }
}

DI void phase_moe2(const Params& p, int l) {
    unsigned char* ws = p.ws;
    moe_sched(p, l);
    const bf16_t* act = (const bf16_t*)(ws + WS_ACT);
    bf16_t* ys = (bf16_t*)(ws + WS_YS);
    const bf16_t* btl = (const bf16_t*)(ws + WS_BTD) + (size_t)l * NEXP * D * DEXP;
    const int G = gridDim.x, total = ((const int*)(smem + LDS_AUX + AUX_MTS))[32] * 4;
    const int full = total / G, n3 = total - full * G;
    const int nsl = n3 == 0 ? 1 : 4 * n3 <= G ? 4 : 2 * n3 <= G ? 2 : 1;
    auto get = [=](int r, UGM& u) { if (nsl > 1 && r >= full) return false; return moe_unit(unit_id(r), 2, u); };
    auto arow = [=](const UGM& u, int r) { int s = u.mt * 256 + r; s = s < u.ce ? s : u.ce - 1; return (unsigned)(u.rb + s) * (DEXP * 2u); };
    auto brow = [=](const UGM& u, int r) { return (unsigned)(u.e * D + u.nt * 256 + prow(r)) * (DEXP * 2u); };
    auto kf = [=](const UGM&) { return DEXP; };
    auto epi = [=](const UGM& u, const acc_t& acc, int wr, int wc, int fr, int fq) {
#pragma unroll
        for (int ai = 0; ai < 2; ++ai)
#pragma unroll
            for (int m = 0; m < 4; ++m) {
                const int s = u.mt * 256 + erow(ai, wr, m, fr);
                if (s < u.ce) {
                    bf16_t* rp = ys + (size_t)(u.rb + s) * D + u.nt * 256;
#pragma unroll
                    for (int bj = 0; bj < 2; ++bj) st8bf(rp + ecol(bj, wc, fq), acc[ai][bj][m][0], acc[ai][bj][m][1]);
                }
            }
    };
    gemm_stream<UGM>((const char*)act, (const char*)btl, get, arow, brow, kf, epi);
    if (nsl > 1) {
        const int v = unit_id(0);
        UGM u;
        if (v < nsl * n3 && moe_unit(full * G + v / nsl, 2, u)) {
            const int sr = u.mt * 256 + (v % nsl) * (256 / nsl);
            if (sr < u.ce) {
                auto sarow = [=](int r) { int s = sr + r; s = s < u.ce ? s : u.ce - 1; return (unsigned)(u.rb + s) * (DEXP * 2u); };
                auto sbrow = [=](int r) { return (unsigned)(u.e * D + u.nt * 256 + prow(r)) * (DEXP * 2u); };
                auto sdst = [=](int row, int c16) { const int s = sr + row; return s < u.ce ? ys + (size_t)(u.rb + s) * D + u.nt * 256 + c16 * 8 : (bf16_t*)nullptr; };
                if (nsl == 4) gemm_slice<2, 2>((const char*)act, (const char*)btl, DEXP / 64, sarow, sbrow, [=](const f32x4 (&acc)[2][4], int m, int q, f32x4& a, f32x4& b) { a = acc[m][2 * q]; b = acc[m][2 * q + 1]; }, sdst);
                else gemm_slice<4, 2>((const char*)act, (const char*)btl, DEXP / 64, sarow, sbrow, [=](const f32x4 (&acc)[4][4], int m, int q, f32x4& a, f32x4& b) { a = acc[m][2 * q]; b = acc[m][2 * q + 1]; }, sdst);
            }
        }
    }
}

template <int DQK, bool SBM>
DI void attn_unit(const bf16_t* __restrict__ Qb, const int qstr, const bf16_t* __restrict__ Kb, const int kstr, const bf16_t* __restrict__ Vb, const int vstr, bf16_t* Ob, const int qt,
                  const bf16_t* __restrict__ Rb = nullptr, const float* __restrict__ csb = nullptr) {
    constexpr int KSTR = DQK * 2 + 16, KBUF = 64 * KSTR, VBUF = 8192, OFF_V = 2 * KBUF;
    constexpr int CPR = DQK / 8, NCH = 64 * CPR, NKC = (NCH + NTHR - 1) / NTHR, NKS = DQK / 16;
    const int tid = otid(), lane = tid & 63, w = __builtin_amdgcn_readfirstlane(tid >> 6), r32 = lane & 31, hh = lane >> 5;
    const int q0 = qt * 256, qmin = q0 + 32 * w, myq = qmin + r32;
    const int NTL = 4 * qt + 4;
    bf16x8 qf[NKS];
#pragma unroll
    for (int ks = 0; ks < NKS; ++ks) qf[ks] = *(const bf16x8*)(Qb + (size_t)myq * qstr + ks * 16 + hh * 8);
    if (DQK == 96) {
        const float* c = csb + (size_t)myq * 32 + 8 * hh;
        const f32x4 c0 = *(const f32x4*)c, c1 = *(const f32x4*)(c + 4), s0 = *(const f32x4*)(c + 16), s1 = *(const f32x4*)(c + 20);
        const u32x4 w1 = __builtin_bit_cast(u32x4, qf[NKS - 2]), w2 = __builtin_bit_cast(u32x4, qf[NKS - 1]);
        const f32x4 t1a = bf4(w1.x, w1.y), t1b = bf4(w1.z, w1.w), t2a = bf4(w2.x, w2.y), t2b = bf4(w2.z, w2.w);
        const f32x4 o1a = t1a * c0 - t2a * s0, o1b = t1b * c1 - t2b * s1, o2a = t1a * s0 + t2a * c0, o2b = t1b * s1 + t2b * c1;
        u32x4 r1, r2;
        r1.x = cvtpk(o1a[0], o1a[1]); r1.y = cvtpk(o1a[2], o1a[3]); r1.z = cvtpk(o1b[0], o1b[1]); r1.w = cvtpk(o1b[2], o1b[3]);
        r2.x = cvtpk(o2a[0], o2a[1]); r2.y = cvtpk(o2a[2], o2a[3]); r2.z = cvtpk(o2b[0], o2b[1]); r2.w = cvtpk(o2b[2], o2b[3]);
        qf[NKS - 2] = __builtin_bit_cast(bf16x8, r1); qf[NKS - 1] = __builtin_bit_cast(bf16x8, r2);
    }
    f32x16 o[2];
#pragma unroll
    for (int i = 0; i < 16; ++i) { o[0][i] = 0.f; o[1][i] = 0.f; }
    float mrun = 0.f, lrun = 0.f, Lrun = 1.0f;
    f32x16 negm;
#pragma unroll
    for (int i = 0; i < 16; ++i) negm[i] = 0.f;
    u32x4 rkA[NKC], rvA, rkB[NKC], rvB;
    auto gload = [&](int j, u32x4 (&rk)[NKC], u32x4& rv) {
        if (DQK == 96) {
            rk[0] = *(const u32x4*)(Kb + (size_t)(64 * j + (tid >> 3)) * kstr + (tid & 7) * 8);
            if (tid < 256) rk[NKC - 1] = *(const u32x4*)(Rb + (size_t)(64 * j + (tid >> 2)) * LATW + (tid & 3) * 8);
        } else {
#pragma unroll
            for (int i = 0; i < NKC; ++i) { const int cid = tid + NTHR * i; if (cid < NCH) { const int row = cid / CPR, c = cid % CPR; rk[i] = *(const u32x4*)(Kb + (size_t)(64 * j + row) * kstr + c * 8); } }
        }
        { const int row = tid >> 3, c = tid & 7; rv = *(const u32x4*)(Vb + (size_t)(64 * j + row) * vstr + c * 8); }
    };
    auto lstore = [&](int buf, const u32x4 (&rk)[NKC], const u32x4& rv) {
        if (DQK == 96) {
            *(u32x4*)(smem + buf * KBUF + (tid >> 3) * KSTR + (tid & 7) * 16) = rk[0];
            if (tid < 256) *(u32x4*)(smem + buf * KBUF + (tid >> 2) * KSTR + (8 + (tid & 3)) * 16) = rk[NKC - 1];
        } else {
#pragma unroll
            for (int i = 0; i < NKC; ++i) { const int cid = tid + NTHR * i; if (cid < NCH) { const int row = cid / CPR, c = cid % CPR; *(u32x4*)(smem + buf * KBUF + row * KSTR + c * 16) = rk[i]; } }
        }
        { const int row = tid >> 3, c = tid & 7; *(u32x4*)(smem + OFF_V + buf * VBUF + (c >> 2) * 4096 + row * 64 + (c & 3) * 16) = rv; }
    };
    unsigned* flags = (unsigned*)(smem + LDS_AUX + AUX_FLAGS);
#define RAW_BARRIER() asm volatile("s_waitcnt lgkmcnt(0)\n\ts_barrier" ::: "memory")
    gload(SBM ? NTL - 1 : 0, rkA, rvA); lstore(0, rkA, rvA);
    gload(SBM ? NTL - 2 : 1, rkA, rvA);
    RAW_BARRIER();
    bool done = false;
    auto step = [&](const int it, u32x4 (&rkH)[NKC], u32x4& rvH, u32x4 (&rkL)[NKC], u32x4& rvL) {
        const int j = SBM ? NTL - 1 - it : it, buf = it & 1;
        if (it + 2 < NTL) gload(SBM ? j - 2 : j + 2, rkL, rvL);
        const int kmin = 64 * j;
        const bool none = SBM ? (kmin >= qmin + 31 || !__any(Lrun > 0.f)) : (kmin > qmin + 31);
        if (!none) {
            const bool full = SBM ? (kmin + 63 < qmin) : (kmin + 63 <= qmin);
            f32x16 s[2];
            bf16x8 kf[2][NKS], vf[2][4];
#pragma unroll
            for (int ks = 0; ks < NKS; ++ks)
#pragma unroll
                for (int kb = 0; kb < 2; ++kb) kf[kb][ks] = *(const bf16x8*)(smem + buf * KBUF + (32 * kb + r32) * KSTR + ks * 32 + hh * 16);
#pragma unroll
            for (int ks = 0; ks < NKS; ++ks)
#pragma unroll
                for (int kb = 0; kb < 2; ++kb) s[kb] = MFMA(kf[kb][ks], qf[ks], ks == 0 ? negm : s[kb]);
            {
                typedef short v4i16_t __attribute__((ext_vector_type(4)));
                typedef __attribute__((address_space(3))) v4i16_t* lds_v4p;
                const int vbase = OFF_V + buf * VBUF + ((lane >> 4) & 1) * 32 + (lane & 3) * 8 + (4 * hh + ((lane & 15) >> 2)) * 64;
#pragma unroll
                for (int kx = 0; kx < 4; ++kx)
#pragma unroll
                    for (int db = 0; db < 2; ++db) {
                        const v4i16_t lo = __builtin_amdgcn_ds_read_tr16_b64_v4i16((lds_v4p)(smem + vbase + db * 4096 + kx * 1024));
                        const v4i16_t hi = __builtin_amdgcn_ds_read_tr16_b64_v4i16((lds_v4p)(smem + vbase + db * 4096 + kx * 1024 + 512));
                        vf[db][kx] = (bf16x8){lo[0], lo[1], lo[2], lo[3], hi[0], hi[1], hi[2], hi[3]};
                    }
            }
            if (!SBM) {
                if (!full) {
#pragma unroll
                    for (int kb = 0; kb < 2; ++kb)
#pragma unroll
                        for (int i = 0; i < 16; ++i) if (kmin + 32 * kb + crow(i, hh) > myq) s[kb][i] = -INFINITY;
                }
                float mx = s[0][0];
#pragma unroll
                for (int kb = 0; kb < 2; ++kb)
#pragma unroll
                    for (int i = 0; i < 16; ++i) mx = fmaxf(mx, s[kb][i]);
                mx = fmaxf(mx, xhalf(mx));
                if (it == 0 || __any(mx > 8.0f)) {
                    const float d = it == 0 ? mx : fmaxf(mx, 0.f);
                    mrun += d;
                    const float al = it == 0 ? 1.0f : fexp2(-d);
                    lrun *= al;
#pragma unroll
                    for (int kb = 0; kb < 2; ++kb)
#pragma unroll
                        for (int i = 0; i < 16; ++i) s[kb][i] -= d;
#pragma unroll
                    for (int i = 0; i < 16; ++i) { o[0][i] *= al; o[1][i] *= al; negm[i] = -mrun; }
                }
                float rs = 0.f;
#pragma unroll
                for (int kb = 0; kb < 2; ++kb)
#pragma unroll
                    for (int i = 0; i < 16; ++i) { const float pz = fexp2(s[kb][i]); s[kb][i] = pz; rs += pz; }
                lrun += rs;
            } else {
                f32x16 kp[2];
#pragma unroll
                for (int kb = 0; kb < 2; ++kb)
#pragma unroll
                    for (int i = 0; i < 16; ++i) {
                        const float u = fexp2(fminf(s[kb][i], 100.0f));
                        float k_ = frcp(1.0f + u), b_ = u * k_;
                        if (!full && !(kmin + 32 * kb + crow(i, hh) < myq)) { k_ = 1.0f; b_ = 0.f; }
                        kp[kb][i] = k_; s[kb][i] = b_;
                    }
                float run = Lrun;
#pragma unroll
                for (int kb = 1; kb >= 0; --kb)
#pragma unroll
                    for (int g = 3; g >= 0; --g) {
                        const float G = (kp[kb][4 * g] * kp[kb][4 * g + 1]) * (kp[kb][4 * g + 2] * kp[kb][4 * g + 3]);
                        const float Gp = xhalf(G);
                        float a_ = hh ? run : run * Gp;
#pragma unroll
                        for (int jl = 3; jl >= 0; --jl) {
                            const int i = 4 * g + jl;
                            s[kb][i] *= a_;
                            a_ *= kp[kb][i];
                        }
                        run *= G * Gp;
                    }
                Lrun = run;
            }
#pragma unroll
            for (int kb = 0; kb < 2; ++kb)
#pragma unroll
                for (int sx = 0; sx < 2; ++sx) {
                    u32x4 pw;
                    pw.x = cvtpk(s[kb][8 * sx], s[kb][8 * sx + 1]); pw.y = cvtpk(s[kb][8 * sx + 2], s[kb][8 * sx + 3]);
                    pw.z = cvtpk(s[kb][8 * sx + 4], s[kb][8 * sx + 5]); pw.w = cvtpk(s[kb][8 * sx + 6], s[kb][8 * sx + 7]);
                    const bf16x8 pk = __builtin_bit_cast(bf16x8, pw);
#pragma unroll
                    for (int db = 0; db < 2; ++db) o[db] = MFMA(vf[db][2 * kb + sx], pk, o[db]);
                }
        }
        if (it + 1 < NTL) lstore(buf ^ 1, rkH, rvH);
        if (SBM) { const bool alive = __any(Lrun > 0.f); if (lane == 0) flags[(it & 1) * 8 + w] = alive ? 1u : 0u; }
        RAW_BARRIER();
        if (SBM) {
            unsigned f = 0u;
#pragma unroll
            for (int q = 0; q < 8; ++q) f |= flags[(it & 1) * 8 + q];
            if (f == 0u) done = true;
        }
    };
    for (int it = 0; it < NTL && !done; it += 2) {
        step(it, rkA, rvA, rkB, rvB);
        if (done) break;
        step(it + 1, rkB, rvB, rkA, rvA);
    }
    float inv = 1.0f;
    if (!SBM) { const float lt = lrun + xhalf(lrun); inv = 1.0f / lt; }
#pragma unroll
    for (int db = 0; db < 2; ++db)
#pragma unroll
        for (int g = 0; g < 4; ++g)
            st4bf(Ob + (size_t)myq * D + 32 * db + 8 * g + 4 * hh, o[db][4 * g] * inv, o[db][4 * g + 1] * inv, o[db][4 * g + 2] * inv, o[db][4 * g + 3] * inv);
    RAW_BARRIER();
#undef RAW_BARRIER
}

DI void sb_wave(const bf16_t* __restrict__ Qb, const bf16_t* __restrict__ Kb, const bf16_t* __restrict__ Vb, bf16_t* Ob, const int Q0_) {
    const int Q0 = __builtin_amdgcn_readfirstlane(Q0_);
    const int tid = otid(), lane = tid & 63, w = __builtin_amdgcn_readfirstlane(tid >> 6), r32 = lane & 31, hh = lane >> 5;
    char* kl = smem + w * 16384; char* vl = kl + 8192;
    const int myq = Q0 + r32, jt = Q0 >> 6;
    bf16x8 qf[4];
#pragma unroll
    for (int ks = 0; ks < 4; ++ks) qf[ks] = *(const bf16x8*)(Qb + (size_t)myq * 512 + ks * 16 + hh * 8);
    f32x16 o[2];
#pragma unroll
    for (int i = 0; i < 16; ++i) { o[0][i] = 0.f; o[1][i] = 0.f; }
    float Prun = 1.0f;
    u32x4 rk[8], rv[8];
    const int lrow = lane >> 3, lc = lane & 7;
    auto gloadK = [&](int j) {
#pragma unroll
        for (int i = 0; i < 8; ++i) rk[i] = *(const u32x4*)(Kb + (size_t)(64 * j + lrow + 8 * i) * 512 + lc * 8);
    };
    auto gloadV = [&](int j, int half) {
#pragma unroll
        for (int i = 0; i < 4; ++i) rv[4 * half + i] = *(const u32x4*)(Vb + (size_t)(64 * j + lrow + 8 * (4 * half + i)) * 512 + lc * 8);
    };
    auto lstoreK = [&]() {
#pragma unroll
        for (int i = 0; i < 8; ++i) { const int row = lrow + 8 * i; *(u32x4*)(kl + row * 128 + ((lc ^ (row & 7)) * 16)) = rk[i]; }
    };
    auto lstoreV = [&]() {
#pragma unroll
        for (int i = 0; i < 8; ++i) { const int row = lrow + 8 * i; *(u32x4*)(vl + (lc >> 2) * 4096 + row * 64 + (lc & 3) * 16) = rv[i]; }
    };
    gloadK(jt); lstoreK();
    for (int j = jt; j >= 0; --j) {
        if (j > 0) gloadK(j - 1);
        gloadV(j, 0);
        const int kmin = 64 * j;
        const bool full = j != jt;
        f32x16 s[2];
        {
            bf16x8 kf[2][4];
#pragma unroll
            for (int ks = 0; ks < 4; ++ks)
#pragma unroll
                for (int kb = 0; kb < 2; ++kb) { const int row = 32 * kb + r32; kf[kb][ks] = *(const bf16x8*)(kl + row * 128 + (((2 * ks + hh) ^ (row & 7)) * 16)); }
#pragma unroll
            for (int kb = 0; kb < 2; ++kb)
#pragma unroll
                for (int i = 0; i < 16; ++i) s[kb][i] = 0.f;
#pragma unroll
            for (int ks = 0; ks < 4; ++ks)
#pragma unroll
                for (int kb = 0; kb < 2; ++kb) s[kb] = MFMA(kf[kb][ks], qf[ks], s[kb]);
        }
        gloadV(j, 1);
        f32x16 kp[2];
#pragma unroll
        for (int kb = 0; kb < 2; ++kb)
#pragma unroll
            for (int i = 0; i < 16; ++i) {
                const float u = fexp2(s[kb][i]);
                float k_ = frcp(1.0f + u), b_ = 1.0f - k_;
                if (!full && !(kmin + 32 * kb + crow(i, hh) < myq)) { k_ = 1.0f; b_ = 0.f; }
                kp[kb][i] = k_; s[kb][i] = b_;
            }
        float run = Prun;
#pragma unroll
        for (int kb = 1; kb >= 0; --kb)
#pragma unroll
            for (int g = 3; g >= 0; --g) {
                const float G = (kp[kb][4 * g] * kp[kb][4 * g + 1]) * (kp[kb][4 * g + 2] * kp[kb][4 * g + 3]);
                const float Gp = xhalf(G);
                float a_ = hh ? run : run * Gp;
#pragma unroll
                for (int jl = 3; jl >= 0; --jl) { const int i = 4 * g + jl; s[kb][i] *= a_; a_ *= kp[kb][i]; }
                run *= G * Gp;
            }
        Prun = run;
        lstoreV();
        bf16x8 vf[2][4];
        {
            typedef short v4i16_t __attribute__((ext_vector_type(4)));
            typedef __attribute__((address_space(3))) v4i16_t* lds_v4p;
            const char* vbase = vl + ((lane >> 4) & 1) * 32 + (lane & 3) * 8 + (4 * hh + ((lane & 15) >> 2)) * 64;
#pragma unroll
            for (int kx = 0; kx < 4; ++kx)
#pragma unroll
                for (int db = 0; db < 2; ++db) {
                    const v4i16_t lo = __builtin_amdgcn_ds_read_tr16_b64_v4i16((lds_v4p)(vbase + db * 4096 + kx * 1024));
                    const v4i16_t hi = __builtin_amdgcn_ds_read_tr16_b64_v4i16((lds_v4p)(vbase + db * 4096 + kx * 1024 + 512));
                    vf[db][kx] = (bf16x8){lo[0], lo[1], lo[2], lo[3], hi[0], hi[1], hi[2], hi[3]};
                }
        }
#pragma unroll
        for (int kb = 0; kb < 2; ++kb)
#pragma unroll
            for (int sx = 0; sx < 2; ++sx) {
                u32x4 pw;
                pw.x = cvtpk(s[kb][8 * sx], s[kb][8 * sx + 1]); pw.y = cvtpk(s[kb][8 * sx + 2], s[kb][8 * sx + 3]);
                pw.z = cvtpk(s[kb][8 * sx + 4], s[kb][8 * sx + 5]); pw.w = cvtpk(s[kb][8 * sx + 6], s[kb][8 * sx + 7]);
                const bf16x8 pk = __builtin_bit_cast(bf16x8, pw);
#pragma unroll
                for (int db = 0; db < 2; ++db) o[db] = MFMA(vf[db][2 * kb + sx], pk, o[db]);
            }
        if (!__any(Prun > 0.f)) break;
        if (j > 0) lstoreK();
    }
#pragma unroll
    for (int db = 0; db < 2; ++db)
#pragma unroll
        for (int g = 0; g < 4; ++g)
            st4bf(Ob + (size_t)myq * D + 32 * db + 8 * g + 4 * hh, o[db][4 * g], o[db][4 * g + 1], o[db][4 * g + 2], o[db][4 * g + 3]);
}

DI void phase_attn(const Params& p, int l) {
    unsigned char* ws = p.ws;
    int* slot = (int*)(smem + LDS_AUX + AUX_SLOT);
    bf16_t* mg = (bf16_t*)(ws + WS_HBUF);
    auto fetch = [&](unsigned* head) { int v = 0; if (otid() == 0) v = (int)__hip_atomic_fetch_add(head, 1u, __ATOMIC_RELAXED, __HIP_MEMORY_SCOPE_AGENT); return v; };
    auto share = [&](int v) { __syncthreads(); if (otid() == 0) *slot = v; __syncthreads(); return *slot; };
    {
        unsigned* head = (unsigned*)(ws + WS_CTL) + CW_ATTQ + 64 * l;
        const bf16_t* qm = (const bf16_t*)(ws + WS_QM); const bf16_t* km = (const bf16_t*)(ws + WS_KM); const bf16_t* lat = (const bf16_t*)(ws + WS_LAT); const float* cs = (const float*)(ws + WS_CS);
        int u = share(fetch(head));
        while (u < 1024) {
            const int nx = fetch(head);
            const int qt = 7 - (u >> 7), bh = u & 127, b = bh >> 3, h = bh & 7;
            const size_t t0 = (size_t)b * SEQ;
            attn_unit<96, false>(qm + t0 * 768 + h * 96, 768, km + (t0 * 8 + h) * KVREC, 8 * KVREC, km + (t0 * 8 + h) * KVREC + 64, 8 * KVREC, mg + t0 * D + 512 + h * 64, qt, lat + t0 * LATW + 384, cs + t0 * 32);
            u = share(nx);
        }
    }
    {
        unsigned* head = (unsigned*)(ws + WS_CTL) + CW_ATTQ + 64 * (l + DEPTH);
        const bf16_t* sbq = (const bf16_t*)(ws + WS_SBQ); const bf16_t* sbk = (const bf16_t*)(ws + WS_SBK); const bf16_t* sbv = (const bf16_t*)(ws + WS_SBV);
        int u = share(fetch(head));
        while (u < 1024) {
            const int nx = fetch(head);
            const int qt = 7 - (u >> 7), bh = u & 127, b = bh >> 3, h = bh & 7;
            const size_t t0 = (size_t)b * SEQ;
            sb_wave(sbq + t0 * 512 + h * 64, sbk + t0 * 512 + h * 64, sbv + t0 * 512 + h * 64, mg + t0 * D + h * 64, qt * 256 + 32 * (int)(otid() >> 6));
            u = share(nx);
        }
    }
}

#ifndef TIMEPH
#define TIMEPH -1
#endif
#define PHASE(id, call, sync) do { if (TIMEPH == (id)) ts_ = __builtin_amdgcn_s_memrealtime(); call; if ((sync) || TIMEPH == (id)) xcd_barrier(bar); \
                                   if (TIMEPH == (id)) tacc_ += __builtin_amdgcn_s_memrealtime() - ts_; } while (0)
__global__ void __launch_bounds__(NTHR, 2) fwd_kernel(Params p) {
    if (threadIdx.x == 0) *(uint4*)(smem + LDS_BAR) = make_uint4(0u, 0u, 0u, 0u);
    __syncthreads();
    XcdBarrier bar = xcd_barrier_post((unsigned*)(p.ws + WS_CTL), (volatile LAS unsigned*)(smem + LDS_BAR));
    unsigned long long ts_ = 0, tacc_ = 0;
    PHASE(0, phase0(p), true);
    PHASE(1, phase_ln0(p), true);
    for (int l = 0; l < DEPTH; ++l) {
        PHASE(2, phase_gemm1(p, l), true);
        PHASE(3, phase_mlaprep(p, l), true);
        PHASE(4, phase_attn(p, l), true);
        PHASE(5, phase_wo(p, l), true);
        PHASE(6, if (l == 0) phase_ln1<false>(p, l); else phase_ln1<true>(p, l), true);
        PHASE(8, phase_moe1(p, l), true);
        PHASE(9, phase_moe2(p, l), true);
        PHASE(10, phase_ln2(p, l, p.out), l + 1 < DEPTH);
    }
    if (TIMEPH >= 0) { const unsigned long long te = __builtin_amdgcn_s_memrealtime(); while (__builtin_amdgcn_s_memrealtime() - te < tacc_) __builtin_amdgcn_s_sleep(8); }
}

extern "C" void kernel_launch(void* const* d_in, const int* in_sizes, int n_in, void* d_out, int out_size, void* d_ws, size_t ws_size, hipStream_t stream) {
    static int grid = 0;
    if (grid == 0) {
        if (n_in != 20 || out_size != NTOK * D || ws_size < WS_END) { fprintf(stderr, "kernel_launch: unexpected shapes (n_in %d, out %d, ws %zu, need %zu)\n", n_in, out_size, ws_size, (size_t)WS_END); grid = -1; return; }
        int dev = 0, cus = 0, per_cu = 0;
        if (hipGetDevice(&dev) != hipSuccess || hipDeviceGetAttribute(&cus, hipDeviceAttributeMultiprocessorCount, dev) != hipSuccess) { grid = -1; return; }
        if (hipFuncSetAttribute((const void*)fwd_kernel, hipFuncAttributeMaxDynamicSharedMemorySize, LDS_BYTES) != hipSuccess) { fprintf(stderr, "kernel_launch: hipFuncSetAttribute failed\n"); grid = -1; return; }
        if (hipOccupancyMaxActiveBlocksPerMultiprocessor(&per_cu, (const void*)fwd_kernel, NTHR, LDS_BYTES) != hipSuccess || per_cu < 1) { fprintf(stderr, "kernel_launch: occupancy query failed (%d)\n", per_cu); per_cu = 1; }
        (void)hipGetLastError();
        grid = cus;
    }
    if (grid < 0) return;
    (void)hipMemsetAsync((char*)d_ws + WS_CTL, 0, CTL_BYTES + SS_BYTES, stream);
    Params p{};
    p.x = (const float*)d_in[0]; p.c = (const float*)d_in[1]; p.pos = (const int*)d_in[2];
    p.ada_w = (const float*)d_in[3]; p.ada_b = (const float*)d_in[4]; p.w_in = (const float*)d_in[5]; p.q_norm = (const float*)d_in[6]; p.kv_norm = (const float*)d_in[7];
    p.w_uq = (const float*)d_in[8]; p.w_ukv = (const float*)d_in[9]; p.w_o = (const float*)d_in[10]; p.ln1_g = (const float*)d_in[11]; p.ln1_b = (const float*)d_in[12];
    p.router_w = (const float*)d_in[13]; p.router_bias = (const float*)d_in[14]; p.w_gate = (const float*)d_in[15]; p.w_up = (const float*)d_in[16]; p.w_down = (const float*)d_in[17];
    p.ln2_g = (const float*)d_in[18]; p.ln2_b = (const float*)d_in[19];
    p.out = (float*)d_out; p.ws = (unsigned char*)d_ws;
    hipLaunchKernelGGL(fwd_kernel, dim3(grid), dim3(NTHR), LDS_BYTES, stream, p);
}
```

```cpp
#include <hip/hip_runtime.h>
#include <cstdio>
#include <cstdint>

typedef unsigned short bf16_t;
typedef short bf16x8 __attribute__((ext_vector_type(8)));
typedef float f32x16 __attribute__((ext_vector_type(16)));
typedef float f32x4 __attribute__((ext_vector_type(4)));
typedef float f32x2 __attribute__((ext_vector_type(2)));
typedef unsigned u32x4 __attribute__((ext_vector_type(4)));
typedef unsigned u32x2 __attribute__((ext_vector_type(2)));
typedef __bf16 bf16x2_t __attribute__((ext_vector_type(2)));
#define DI __device__ __forceinline__
#define MFMA(a, b, c) __builtin_amdgcn_mfma_f32_32x32x16_bf16((a), (b), (c), 0, 0, 0)

constexpr int D = 1024, NB = 16, SEQ = 2048, NTOK = NB * SEQ, DEPTH = 2;
constexpr int INW = 1952, INWP = 2048;
constexpr int NEXP = 32, DEXP = 256;
constexpr int LATW = 416;
constexpr float ALPHA = 1.4142135623730951f;
constexpr float LOG2E = 1.4426950408889634f;

constexpr size_t MiB = 1024 * 1024;
constexpr size_t WS_CTL = 0;
constexpr size_t CTL_BYTES = 65536;
constexpr size_t WS_SS = WS_CTL + CTL_BYTES;
constexpr size_t SS_BYTES = (size_t)DEPTH * 2 * NTOK * 4;
constexpr size_t WS_MOD = WS_SS + SS_BYTES;
constexpr size_t WS_CS = WS_MOD + (size_t)DEPTH * NB * 6144 * 4;
constexpr size_t WS_BTIN = WS_CS + (size_t)NTOK * 32 * 4;
constexpr size_t WS_BTUQ = WS_BTIN + (size_t)DEPTH * INWP * D * 2;
constexpr size_t WS_BTUKV = WS_BTUQ + (size_t)DEPTH * 768 * 256 * 2;
constexpr size_t WS_BTO = WS_BTUKV + (size_t)DEPTH * 1024 * 128 * 2;
constexpr size_t WS_BTGU = WS_BTO + (size_t)DEPTH * D * D * 2;
constexpr size_t WS_BTD = WS_BTGU + (size_t)DEPTH * NEXP * 512 * D * 2;
constexpr size_t WS_BTR = WS_BTD + (size_t)DEPTH * NEXP * D * DEXP * 2;
constexpr size_t WS_RSTD = WS_BTR + (size_t)256 * D * 2;
constexpr size_t WS_TOKES = WS_RSTD + (size_t)2 * NTOK * 4;
constexpr size_t WS_TOKG = WS_TOKES + (size_t)NTOK * 2 * 4;
constexpr size_t WS_LIST = WS_TOKG + (size_t)NTOK * 2 * 4;
constexpr size_t WS_HBUF = WS_LIST + (size_t)NEXP * NTOK * 4;
constexpr size_t WS_REG = WS_HBUF + (size_t)NTOK * D * 2;
constexpr size_t WS_SBQ = WS_REG;
constexpr size_t WS_SBK = WS_SBQ + (size_t)NTOK * 512 * 2;
constexpr size_t WS_SBV = WS_SBK + (size_t)NTOK * 512 * 2;
constexpr size_t WS_LAT = WS_SBV + (size_t)NTOK * 512 * 2;
constexpr size_t WS_QM = WS_LAT + (size_t)NTOK * LATW * 2;
constexpr size_t WS_KM = WS_QM + (size_t)NTOK * 768 * 2;
constexpr int KVREC = 128;
constexpr size_t WS_ATT_END = WS_KM + (size_t)NTOK * 8 * KVREC * 2;
constexpr size_t WS_X1 = WS_REG;
constexpr size_t WS_YS = WS_X1 + (size_t)NTOK * D * 4;
constexpr size_t WS_ACT = WS_YS + (size_t)2 * NTOK * D * 2;
constexpr size_t WS_MIX = WS_YS;
constexpr size_t WS_FFN_END = WS_ACT + (size_t)2 * NTOK * DEXP * 2;
constexpr size_t WS_XB = WS_ACT;
static_assert(WS_ACT >= WS_ATT_END, "XB must lie behind the attention-time view");
constexpr size_t WS_XB_END = WS_XB + (size_t)NTOK * D * 2;
constexpr size_t WS_END0 = WS_ATT_END > WS_FFN_END ? WS_ATT_END : WS_FFN_END;
constexpr size_t WS_END = WS_END0 > WS_XB_END ? WS_END0 : WS_XB_END;

constexpr int CW_ATTQ = 4096;
constexpr int CW_CONVQ = 4096 + 64 * 3 + 32;
constexpr int CW_CNT = 4352;
constexpr int CW_BASE = 8448;

constexpr int TILE_B = 256 * 64 * 2;
constexpr int STAGE_B = 2 * TILE_B;
constexpr int LDS_AUX = 150 * 1024;
constexpr int AUX_ROWSS = 0, AUX_FLAGS = 1024, AUX_SLOT = 1088, AUX_HIST = 1152, AUX_CNTS = 1536, AUX_MTS = 1792, AUX_RBS = 2048;
constexpr int LDS_BAR = LDS_AUX + 4096;
constexpr int LDS_BYTES = LDS_BAR + 16;
constexpr int NTHR = 512, NWAVE = 8;
extern __shared__ __attribute__((aligned(1024))) char smem[];

#define XB_TMO      128
#define XB_XCNT(j)  (256  + 64 * (j))
#define XB_XSUB(j)  (1280 + 64 * (j))
#define XB_XGEN(j)  (2304 + 64 * (j))
#define XB_TOP      3328
#define XB_TOPGEN   3392
#define XCD_BAR_WORDS 3456
#define XB_SPIN_CAP (1u << 20)
#define LAS __attribute__((address_space(3)))
DI unsigned xb_ld(unsigned* p)              { return __hip_atomic_load(p, __ATOMIC_RELAXED, __HIP_MEMORY_SCOPE_AGENT); }
DI unsigned xb_add(unsigned* p, unsigned v) { return __hip_atomic_fetch_add(p, v, __ATOMIC_RELAXED, __HIP_MEMORY_SCOPE_AGENT); }
DI unsigned xb_xcc_id() { return (unsigned)__builtin_amdgcn_s_getreg((3 << 11) | 20) & 0xFu; }
#define XB_SPIN(cond, bar) do { unsigned _sp = 0; while (cond) { __builtin_amdgcn_s_sleep(1); \
    if ((++_sp & 255u) == 0u) { if (xb_ld(&(bar)[XB_TMO])) break; if (_sp > XB_SPIN_CAP) { atomicAdd(&(bar)[XB_TMO], 1u); break; } } } } while (0)
struct XcdBarrier { unsigned* bar; unsigned x; volatile LAS unsigned* st; };
DI XcdBarrier xcd_barrier_post(unsigned* bar, volatile LAS unsigned* st) {
    XcdBarrier b; b.bar = bar; b.x = xb_xcc_id(); b.st = st;
    if (threadIdx.x == 0) (void)xb_add(&bar[XB_XCNT(b.x)], 1u);
    return b;
}
DI void xcd_barrier_complete(unsigned* bar, unsigned x, unsigned& nloc, unsigned& nx) {
    const unsigned G = gridDim.x * gridDim.y * gridDim.z;
    unsigned sum, cnt, mine, sp = 0u;
    for (;;) {
        sum = 0u; cnt = 0u; mine = 0u;
#pragma unroll
        for (unsigned j = 0; j < 16; ++j) { const unsigned c = xb_ld(&bar[XB_XCNT(j)]); sum += c; cnt += (c > 0u) ? 1u : 0u; mine = (j == x) ? c : mine; }
        if (sum == G) break;
        __builtin_amdgcn_s_sleep(1);
        if ((++sp & 255u) == 0u) { if (xb_ld(&bar[XB_TMO])) break; if (sp > XB_SPIN_CAP) { atomicAdd(&bar[XB_TMO], 1u); break; } }
    }
    nloc = mine > 0u ? mine : 1u; nx = cnt > 0u ? cnt : 1u;
}
DI void xcd_barrier(const XcdBarrier& b_) {
    XcdBarrier b; b.bar = b_.bar; b.x = xb_xcc_id(); b.st = (volatile LAS unsigned*)(smem + LDS_BAR);
    asm volatile("s_waitcnt vmcnt(0)" ::: "memory");
    __syncthreads();
    if (threadIdx.x == 0) {
        unsigned* bar = b.bar;
        __builtin_amdgcn_s_waitcnt(0);
        unsigned nloc = b.st[0], nx = b.st[1];
        if (nloc == 0u) { xcd_barrier_complete(bar, b.x, nloc, nx); b.st[0] = nloc; b.st[1] = nx; }
        const unsigned old = xb_add(&bar[XB_XSUB(b.x)], 1u);
        const unsigned gen = old / nloc;
        if (old + 1u == (gen + 1u) * nloc) {
            __builtin_amdgcn_fence(__ATOMIC_RELEASE, "agent");
            asm volatile("s_waitcnt vmcnt(0)" ::: "memory");
            const unsigned og = xb_add(&bar[XB_TOP], 1u);
            const unsigned tg = og / nx;
            if (og + 1u == (tg + 1u) * nx) xb_add(&bar[XB_TOPGEN], 1u);
            else XB_SPIN(xb_ld(&bar[XB_TOPGEN]) == tg, bar);
            __builtin_amdgcn_fence(__ATOMIC_ACQUIRE, "agent");
            xb_add(&bar[XB_XGEN(b.x)], 1u);
            asm volatile("s_waitcnt vmcnt(0)" ::: "memory");
        } else {
            XB_SPIN(xb_ld(&bar[XB_XGEN(b.x)]) == gen, bar);
            __builtin_amdgcn_fence(__ATOMIC_ACQUIRE, "agent");
            asm volatile("s_waitcnt vmcnt(0)" ::: "memory");
        }
    }
    __syncthreads();
}

DI float bf2f(unsigned v16) { return __uint_as_float(v16 << 16); }
DI unsigned cvtpk(float lo, float hi) { f32x2 v = {lo, hi}; bf16x2_t b = __builtin_convertvector(v, bf16x2_t); return __builtin_bit_cast(unsigned, b); }
DI int crow(int i, int h) { return (i & 3) + 8 * (i >> 2) + 4 * h; }
DI float dpp_add(float v, const int ctrl_tag) {
    int r;
    if (ctrl_tag == 0) r = __builtin_amdgcn_update_dpp(0, __float_as_int(v), 0xB1, 0xf, 0xf, true);
    else if (ctrl_tag == 1) r = __builtin_amdgcn_update_dpp(0, __float_as_int(v), 0x4E, 0xf, 0xf, true);
    else if (ctrl_tag == 2) r = __builtin_amdgcn_update_dpp(0, __float_as_int(v), 0x124, 0xf, 0xf, true);
    else r = __builtin_amdgcn_update_dpp(0, __float_as_int(v), 0x128, 0xf, 0xf, true);
    return v + __int_as_float(r);
}
DI float wsum(float v) {
    v = dpp_add(v, 0); v = dpp_add(v, 1); v = dpp_add(v, 2); v = dpp_add(v, 3);
    const int iv = __float_as_int(v);
    return (__int_as_float(__builtin_amdgcn_readlane(iv, 0)) + __int_as_float(__builtin_amdgcn_readlane(iv, 16))) +
           (__int_as_float(__builtin_amdgcn_readlane(iv, 32)) + __int_as_float(__builtin_amdgcn_readlane(iv, 48)));
}
DI float xhalf(float v) {
    const unsigned mine = __float_as_uint(v);
    auto rr = __builtin_amdgcn_permlane32_swap(mine, mine, false, false);
    const unsigned a = rr[0], b = rr[1];
    return __uint_as_float(a == mine ? b : a);
}
DI int xhalf_i(int v) {
    const unsigned mine = (unsigned)v;
    auto rr = __builtin_amdgcn_permlane32_swap(mine, mine, false, false);
    const unsigned a = rr[0], b = rr[1];
    return (int)(a == mine ? b : a);
}
DI int otid() { int t = threadIdx.x; asm volatile("" : "+v"(t)); return t; }
DI void st4bf(bf16_t* pz, float a, float b, float c, float d);
DI void st4bf(bf16_t* pz, const f32x4& v);
DI float fexp2(float x) { return __builtin_amdgcn_exp2f(x); }
DI float flog2(float x) { return __builtin_amdgcn_logf(x); }
DI float frcp(float x) { return __builtin_amdgcn_rcpf(x); }
DI float sigmoidf_(float x) { return frcp(1.0f + fexp2(-x * LOG2E)); }

struct Params {
    const float *x, *c; const int* pos;
    const float *ada_w, *ada_b, *w_in, *q_norm, *kv_norm, *w_uq, *w_ukv, *w_o, *ln1_g, *ln1_b, *router_w, *router_bias, *w_gate, *w_up, *w_down, *ln2_g, *ln2_b;
    float* out; unsigned char* ws;
};


DI int lds_byte(int r, int c) { const int st = (r >> 4) * 2 + (c >> 5), ob = (r & 15) * 64 + (c & 31) * 2; return st * 1024 + (ob ^ (((ob >> 9) & 1) << 5)); }
DI void stage_rc(int b, int& R, int& C) { const int st = b >> 10, sb = b & 1023, swz = sb ^ (((sb >> 9) & 1) << 5); R = (st >> 1) * 16 + swz / 64; C = (st & 1) * 32 + (swz % 64) / 2; }
#define MFMA16(a, b, c) __builtin_amdgcn_mfma_f32_16x16x32_bf16((a), (b), (c), 0, 0, 0)
typedef f32x4 acc_t[2][2][4][2];
constexpr int HTB = 128 * 64 * 2;

template <class U, class Get, class ARow, class BRow, class KF, class Epi>
DI void gemm_stream(const char* abase, const char* bbase, const Get& get, const ARow& arow, const BRow& brow, const KF& kf, const Epi& epi) {
    const int tid = otid(), lane = tid & 63, wid = __builtin_amdgcn_readfirstlane(tid >> 6), wr = wid >> 2, wc = wid & 3, fr = lane & 15, fq = lane >> 4;
    U cur, nxt;
    int r = 0;
    if (!get(0, cur)) return;
    unsigned ao2[2][2], bo2[2][2], a11[2];
    auto setptr = [&](const U& u) {
        const int t2 = otid();
#pragma unroll
        for (int i = 0; i < 2; ++i) {
            int R, C; stage_rc(t2 * 16 + i * 8192, R, C);
#pragma unroll
            for (int h = 0; h < 2; ++h) { ao2[h][i] = arow(u, h * 128 + R) + 2 * C; bo2[h][i] = brow(u, h * 128 + R) + 2 * C; }
        }
    };
    setptr(cur);
    a11[0] = ao2[1][0]; a11[1] = ao2[1][1];
    const int aoff = lds_byte(wr * 64 + fr, fq * 8), boff = lds_byte(wc * 32 + fr, fq * 8);
#define G8_SA(b, h) (((b) * 2 + (h)) * HTB)
#define G8_SB(b, h) ((4 + (b) * 2 + (h)) * HTB)
#define G8_STAGE(bufoff, base, o0, o1, kt) do { \
        __builtin_amdgcn_global_load_lds((const unsigned*)((base) + (o0) + (kt) * 128), (unsigned*)(smem + (bufoff) + wid * 1024), 16, 0, 0); \
        __builtin_amdgcn_global_load_lds((const unsigned*)((base) + (o1) + (kt) * 128), (unsigned*)(smem + (bufoff) + wid * 1024 + 8192), 16, 0, 0); } while (0)
#define G8_LDA(dst, b, h) do { _Pragma("unroll") for (int m = 0; m < 4; ++m) _Pragma("unroll") for (int k = 0; k < 2; ++k) dst[m][k] = *(const bf16x8*)(smem + G8_SA(b, h) + aoff + m * 2048 + k * 1024); } while (0)
#define G8_LDB(dst, b, h) do { _Pragma("unroll") for (int n = 0; n < 2; ++n) _Pragma("unroll") for (int k = 0; k < 2; ++k) dst[n][k] = *(const bf16x8*)(smem + G8_SB(b, h) + boff + n * 2048 + k * 1024); } while (0)
#define G8_MMA(ai, bj, At_, Bt_) do { __builtin_amdgcn_s_setprio(1); _Pragma("unroll") for (int m = 0; m < 4; ++m) _Pragma("unroll") for (int n = 0; n < 2; ++n) _Pragma("unroll") for (int k = 0; k < 2; ++k) \
        acc[ai][bj][m][n] = MFMA16(Bt_[n][k], At_[m][k], acc[ai][bj][m][n]); __builtin_amdgcn_s_setprio(0); } while (0)
#define G8_WAIT_V(n) asm volatile("s_waitcnt vmcnt(" #n ")" ::: "memory")
#define G8_WAIT_L(n) asm volatile("s_waitcnt lgkmcnt(" #n ")" ::: "memory")
#define G8_BAR __builtin_amdgcn_s_barrier()
#define G8_SCHED __builtin_amdgcn_sched_barrier(0)
    __syncthreads();
    G8_STAGE(G8_SB(0, 0), bbase, bo2[0][0], bo2[0][1], 0); G8_STAGE(G8_SA(0, 0), abase, ao2[0][0], ao2[0][1], 0);
    G8_STAGE(G8_SB(0, 1), bbase, bo2[1][0], bo2[1][1], 0); G8_STAGE(G8_SA(0, 1), abase, ao2[1][0], ao2[1][1], 0);
    if (wr == 1) G8_BAR;
    G8_WAIT_V(4); G8_BAR;
    G8_STAGE(G8_SB(1, 0), bbase, bo2[0][0], bo2[0][1], 1); G8_STAGE(G8_SA(1, 0), abase, ao2[0][0], ao2[0][1], 1); G8_STAGE(G8_SB(1, 1), bbase, bo2[1][0], bo2[1][1], 1);
    G8_WAIT_V(6); G8_BAR;
    for (;;) {
        const int KT = kf(cur) >> 6;
        const bool has_next = get(r + 1, nxt);
        acc_t acc;
#pragma unroll
        for (int a = 0; a < 2; ++a)
#pragma unroll
            for (int b = 0; b < 2; ++b)
#pragma unroll
                for (int m = 0; m < 4; ++m)
#pragma unroll
                    for (int n = 0; n < 2; ++n) acc[a][b][m][n] = (f32x4){0.f, 0.f, 0.f, 0.f};
        bf16x8 At[4][2], B0[2][2], B1[2][2];
#pragma unroll 1
        for (int t = 0; t < KT; t += 2) {
            const bool last = (t == KT - 2);
            if (last && has_next) setptr(nxt);
            const int kt1 = t + 1, kt2 = last ? 0 : t + 2, kt3 = kt2 + 1;
            G8_LDB(B0, 0, 0); G8_SCHED; G8_LDA(At, 0, 0); G8_STAGE(G8_SA(1, 1), abase, a11[0], a11[1], kt1);
            G8_WAIT_L(8); G8_BAR; G8_WAIT_L(0); G8_MMA(0, 0, At, B0); G8_BAR; G8_SCHED;
            G8_LDB(B1, 0, 1); G8_STAGE(G8_SB(0, 0), bbase, bo2[0][0], bo2[0][1], kt2);
            G8_BAR; G8_WAIT_L(0); G8_MMA(0, 1, At, B1); G8_BAR;
            G8_LDA(At, 0, 1); G8_STAGE(G8_SA(0, 0), abase, ao2[0][0], ao2[0][1], kt2);
            G8_BAR; G8_WAIT_L(0); G8_MMA(1, 0, At, B0); G8_BAR; G8_SCHED;
            G8_STAGE(G8_SB(0, 1), bbase, bo2[1][0], bo2[1][1], kt2);
            G8_WAIT_V(6); G8_BAR; G8_MMA(1, 1, At, B1); G8_BAR;
            G8_LDB(B0, 1, 0); G8_SCHED; G8_LDA(At, 1, 0); G8_STAGE(G8_SA(0, 1), abase, ao2[1][0], ao2[1][1], kt2);
            G8_WAIT_L(8); G8_BAR; G8_WAIT_L(0); G8_MMA(0, 0, At, B0); G8_BAR; G8_SCHED;
            G8_LDB(B1, 1, 1); G8_STAGE(G8_SB(1, 0), bbase, bo2[0][0], bo2[0][1], kt3);
            G8_BAR; G8_WAIT_L(0); G8_MMA(0, 1, At, B1); G8_BAR;
            G8_LDA(At, 1, 1); G8_STAGE(G8_SA(1, 0), abase, ao2[0][0], ao2[0][1], kt3);
            G8_BAR; G8_WAIT_L(0); G8_MMA(1, 0, At, B0); G8_BAR; G8_SCHED;
            G8_STAGE(G8_SB(1, 1), bbase, bo2[1][0], bo2[1][1], kt3);
            G8_WAIT_V(6); G8_BAR; G8_MMA(1, 1, At, B1); G8_BAR;
            a11[0] = ao2[1][0]; a11[1] = ao2[1][1];
        }
        if (wr == 0) G8_BAR;
        epi(cur, acc, wr, wc, fr, fq);
        if (!has_next) break;
        if (wr == 1) G8_BAR;
        cur = nxt; ++r;
    }
    G8_WAIT_V(0);
    G8_BAR;
#undef G8_SA
#undef G8_SB
#undef G8_STAGE
#undef G8_LDA
#undef G8_LDB
#undef G8_MMA
#undef G8_WAIT_V
#undef G8_WAIT_L
#undef G8_BAR
#undef G8_SCHED
}

struct ConvJob { const float* src; const float* src2; const float* kscale; bf16_t* dst; int N, K, nvalid, mode, k0, n0p; };
constexpr int CV_PITCH = 516;
DI void conv_load(const ConvJob& J, int tid, f32x4 (&v)[8]) {
    const int kk = tid >> 3, np = J.n0p + (tid & 7) * 32;
    const float* s = J.src; int col;
    if (J.mode == 0) col = np < J.nvalid ? np : -1;
    else if (J.mode == 1) col = np < 512 ? ((np >> 6) * 128 + (np & 63)) : (((np - 512) >> 6) * 128 + 64 + (np & 63));
    else { col = (np >> 8) * 128 + (np & 127); s = ((np >> 7) & 1) ? J.src2 : J.src; }
    const float* rowp = s + (size_t)(J.k0 + kk) * J.N + col;
#pragma unroll
    for (int i = 0; i < 8; ++i) v[i] = (col >= 0) ? *(const f32x4*)(rowp + 4 * i) : (f32x4){0.f, 0.f, 0.f, 0.f};
}
DI void conv_store(const ConvJob& J, int tid, const f32x4 (&v)[8]) {
    const int kk = tid >> 3, ch = tid & 7;
    const float ks = J.kscale ? J.kscale[J.k0 + kk] : 1.0f;
    __syncthreads();
#pragma unroll
    for (int i = 0; i < 8; ++i) {
        *(unsigned*)(smem + kk * CV_PITCH + ch * 64 + i * 8) = cvtpk(v[i][0] * ks, v[i][1] * ks);
        *(unsigned*)(smem + kk * CV_PITCH + ch * 64 + i * 8 + 4) = cvtpk(v[i][2] * ks, v[i][3] * ks);
    }
    __syncthreads();
#pragma unroll
    for (int i = 0; i < 4; ++i) {
        const int c = tid + NTHR * i, n = c >> 3, kc = c & 7;
        unsigned short e[8];
#pragma unroll
        for (int q = 0; q < 8; ++q) e[q] = *(const unsigned short*)(smem + (kc * 8 + q) * CV_PITCH + n * 2);
        u32x4 w;
        w.x = e[0] | ((unsigned)e[1] << 16); w.y = e[2] | ((unsigned)e[3] << 16); w.z = e[4] | ((unsigned)e[5] << 16); w.w = e[6] | ((unsigned)e[7] << 16);
        *(u32x4*)(J.dst + (size_t)(J.n0p + n) * J.K + J.k0 + kc * 8) = w;
    }
}

constexpr int CT_IN = 16 * 8, CT_UQ = 4 * 3, CT_UKV = 2 * 4, CT_O = 16 * 4, CT_GU = 32 * 16 * 2, CT_D = 32 * 4 * 4, CT_R = 16;
constexpr int CC1 = CT_IN, CC2 = CC1 + CT_UQ, CC3 = CC2 + CT_UKV, CC4 = CC3 + CT_O, CC5 = CC4 + CT_GU, CC6 = CC5 + CT_D;
DI ConvJob conv_job(const Params& p, int l, int t) {
    unsigned char* ws = p.ws;
    ConvJob J;
    if (t < CC1) { const int r = t; J = {p.w_in + (size_t)l * D * INW, nullptr, nullptr, (bf16_t*)(ws + WS_BTIN) + (size_t)l * INWP * D, INW, D, INW, 0, (r & 15) * 64, (r >> 4) * 256}; }
    else if (t < CC2) { const int r = t - CC1; J = {p.w_uq + (size_t)l * 256 * 768, nullptr, p.q_norm + l * 256, (bf16_t*)(ws + WS_BTUQ) + (size_t)l * 768 * 256, 768, 256, 768, 0, (r & 3) * 64, (r >> 2) * 256}; }
    else if (t < CC3) { const int r = t - CC2; J = {p.w_ukv + (size_t)l * 128 * 1024, nullptr, p.kv_norm + l * 128, (bf16_t*)(ws + WS_BTUKV) + (size_t)l * 1024 * 128, 1024, 128, 1024, 0, (r & 1) * 64, (r >> 1) * 256}; }
    else if (t < CC4) { const int r = t - CC3; J = {p.w_o + (size_t)l * D * D, nullptr, nullptr, (bf16_t*)(ws + WS_BTO) + (size_t)l * D * D, D, D, D, 0, (r & 15) * 64, (r >> 4) * 256}; }
    else if (t < CC5) { const int u = t - CC4, le = l * NEXP + u / 32, r = u % 32; J = {p.w_gate + (size_t)le * D * DEXP, p.w_up + (size_t)le * D * DEXP, nullptr, (bf16_t*)(ws + WS_BTGU) + (size_t)le * 512 * D, DEXP, D, 512, 2, (r & 15) * 64, (r >> 4) * 256}; }
    else if (t < CC6) { const int u = t - CC5, le = l * NEXP + u / 16, r = u % 16; J = {p.w_down + (size_t)le * DEXP * D, nullptr, nullptr, (bf16_t*)(ws + WS_BTD) + (size_t)le * D * DEXP, D, DEXP, D, 0, (r & 3) * 64, (r >> 2) * 256}; }
    else { const int r = t - CC6; J = {p.router_w, nullptr, nullptr, (bf16_t*)(ws + WS_BTR), NEXP, D, NEXP, 0, r * 64, 0}; }
    return J;
}
DI void conv_run(const Params& p, int l, bool with_router, int first, int stride) {
    const int tid = otid();
    const int n = CC6 + (with_router ? CT_R : 0);
    __syncthreads();
    int it = first;
    if (it < n) {
        f32x4 cur[8], nxt[8];
        ConvJob J = conv_job(p, l, it);
        conv_load(J, tid, cur);
        for (;;) {
            const int itn = it + stride;
            ConvJob Jn = J;
            if (itn < n) { Jn = conv_job(p, l, itn); conv_load(Jn, tid, nxt); }
            conv_store(J, tid, cur);
            if (itn >= n) break;
#pragma unroll
            for (int i = 0; i < 8; ++i) cur[i] = nxt[i];
            J = Jn; it = itn;
        }
    }
    __syncthreads();
}

DI void conv_run_queue(const Params& p, int l, bool with_router, unsigned* head) {
    const int tid = otid();
    const int n = CC6 + (with_router ? CT_R : 0);
    int* slot = (int*)(smem + LDS_AUX + AUX_SLOT);
    auto fetch = [&]() { int v = 0; if (otid() == 0) v = (int)__hip_atomic_fetch_add(head, 1u, __ATOMIC_RELAXED, __HIP_MEMORY_SCOPE_AGENT); return v; };
    auto share = [&](int v) { __syncthreads(); if (otid() == 0) *slot = v; __syncthreads(); return *slot; };
    int it = share(fetch());
    if (it < n) {
        f32x4 cur[8], nxt[8];
        ConvJob J = conv_job(p, l, it);
        conv_load(J, tid, cur);
        for (;;) {
            const int itn = share(fetch());
            ConvJob Jn = J;
            if (itn < n) { Jn = conv_job(p, l, itn); conv_load(Jn, tid, nxt); }
            conv_store(J, tid, cur);
            if (itn >= n) break;
#pragma unroll
            for (int i = 0; i < 8; ++i) cur[i] = nxt[i];
            J = Jn; it = itn;
        }
    }
    __syncthreads();
}

DI void phase0(const Params& p) {
    unsigned char* ws = p.ws;
    const int tid = otid();
    constexpr int N_MOD = 2 * 96, N_CS = NTOK / NTHR;
    for (int it = blockIdx.x; it < N_MOD + N_CS; it += gridDim.x) {
        if (it < N_MOD) {
            const int l = it / 96, n0 = (it % 96) * 64;
            float* sc = (float*)smem;
            __syncthreads();
            for (int i = tid; i < NB * D; i += NTHR) { const float v = p.c[i]; sc[i] = v * sigmoidf_(v); }
            __syncthreads();
            const int n = tid & 63, kq = tid >> 6;
            float acc[16];
#pragma unroll
            for (int b = 0; b < 16; ++b) acc[b] = 0.f;
            const float* wp = p.ada_w + (size_t)l * D * 6144 + n0 + n;
#pragma unroll 2
            for (int k = kq * 128; k < kq * 128 + 128; k += 4) {
                const float w0 = wp[(size_t)k * 6144], w1 = wp[(size_t)(k + 1) * 6144], w2 = wp[(size_t)(k + 2) * 6144], w3 = wp[(size_t)(k + 3) * 6144];
#pragma unroll
                for (int b = 0; b < 16; ++b) { const f32x4 s4 = *(const f32x4*)(sc + b * D + k); acc[b] += (s4[0] * w0 + s4[1] * w1) + (s4[2] * w2 + s4[3] * w3); }
            }
            float* part = (float*)(smem + 65536);
#pragma unroll
            for (int b = 0; b < 16; ++b) part[(kq * 16 + b) * 64 + n] = acc[b];
            __syncthreads();
            for (int i = tid; i < 16 * 64; i += NTHR) {
                const int b = i >> 6, nn = i & 63;
                float v = 0.f;
#pragma unroll
                for (int q = 0; q < 8; ++q) v += part[(q * 16 + b) * 64 + nn];
                ((float*)(ws + WS_MOD))[((size_t)l * NB + b) * 6144 + n0 + nn] = v + p.ada_b[(size_t)l * 6144 + n0 + nn];
            }
        } else {
            const int t = (it - N_MOD) * NTHR + tid;
            const float posf = (float)p.pos[t];
            float* cs = (float*)(ws + WS_CS) + (size_t)t * 32;
#pragma unroll
            for (int i = 0; i < 16; ++i) {
                const float inv = (float)exp2(-(double)i * (13.287712379549449 / 16.0));
                const float ang = posf * inv;
                const double rev = (double)ang * 0.15915494309189535;
                const float fr = (float)(rev - rint(rev));
                cs[i] = __builtin_amdgcn_cosf(fr);
                cs[16 + i] = __builtin_amdgcn_sinf(fr);
            }
        }
    }
    conv_run_queue(p, 0, true, (unsigned*)(ws + WS_CTL) + CW_CONVQ);
}

constexpr int RPW = NTOK / (256 * NWAVE);
struct RowVec { f32x4 v[4]; };
struct RowRaw { u32x4 w[2]; };
DI f32x4 bf4(unsigned a, unsigned b) { return (f32x4){bf2f(a & 0xffffu), bf2f(a >> 16), bf2f(b & 0xffffu), bf2f(b >> 16)}; }
DI void ldvec(RowVec& r, const float* base, int lane) {
#pragma unroll
    for (int i = 0; i < 2; ++i) { r.v[2 * i] = *(const f32x4*)(base + 512 * i + 8 * lane); r.v[2 * i + 1] = *(const f32x4*)(base + 512 * i + 8 * lane + 4); }
}
DI void ldraw(RowRaw& r, const bf16_t* base, int lane) {
#pragma unroll
    for (int i = 0; i < 2; ++i) r.w[i] = *(const u32x4*)(base + 512 * i + 8 * lane);
}
DI void raw2vec(RowVec& r, const RowRaw& q) {
#pragma unroll
    for (int i = 0; i < 2; ++i) { r.v[2 * i] = bf4(q.w[i].x, q.w[i].y); r.v[2 * i + 1] = bf4(q.w[i].z, q.w[i].w); }
}
DI void stvec_bf(bf16_t* base, const f32x4 (&v)[4], int lane) {
#pragma unroll
    for (int i = 0; i < 2; ++i) {
        u32x4 w; w.x = cvtpk(v[2 * i][0], v[2 * i][1]); w.y = cvtpk(v[2 * i][2], v[2 * i][3]); w.z = cvtpk(v[2 * i + 1][0], v[2 * i + 1][1]); w.w = cvtpk(v[2 * i + 1][2], v[2 * i + 1][3]);
        *(u32x4*)(base + 512 * i + 8 * lane) = w;
    }
}
DI void stvec_f32(float* base, const f32x4 (&v)[4], int lane) {
#pragma unroll
    for (int i = 0; i < 2; ++i) { *(f32x4*)(base + 512 * i + 8 * lane) = v[2 * i]; *(f32x4*)(base + 512 * i + 8 * lane + 4) = v[2 * i + 1]; }
}
DI void row_stats2(const f32x4 (&a)[4], const f32x4 (&b)[4], float& mua, float& rsa, float& mub, float& rsb) {
    float sa = 0.f, sb = 0.f;
#pragma unroll
    for (int i = 0; i < 4; ++i) { sa += (a[i][0] + a[i][1]) + (a[i][2] + a[i][3]); sb += (b[i][0] + b[i][1]) + (b[i][2] + b[i][3]); }
    mua = wsum(sa) * (1.0f / D); mub = wsum(sb) * (1.0f / D);
    float qa = 0.f, qb = 0.f;
#pragma unroll
    for (int i = 0; i < 4; ++i)
#pragma unroll
        for (int j = 0; j < 4; ++j) { const float da = a[i][j] - mua, db = b[i][j] - mub; qa += da * da; qb += db * db; }
    rsa = __builtin_amdgcn_rsqf(wsum(qa) * (1.0f / D) + 1e-5f); rsb = __builtin_amdgcn_rsqf(wsum(qb) * (1.0f / D) + 1e-5f);
}
DI void lds_vec_fill(int slot, const float* src, int tid) { for (int i = tid; i < D / 4; i += NTHR) *(f32x4*)(smem + 4096 * slot + 16 * i) = *(const f32x4*)(src + 4 * i); }
DI f32x4 lv(int slot, int i, int lane) { return *(const f32x4*)(smem + 4096 * slot + (512 * (i >> 1) + 8 * lane + 4 * (i & 1)) * 4); }
DI void modulate_store2(const f32x4 (&a)[4], const f32x4 (&b)[4], int sl_shift, int sl_scale, bf16_t* ha, bf16_t* hb_, int lane) {
    float mua, rsa, mub, rsb; row_stats2(a, b, mua, rsa, mub, rsb);
    f32x4 oa[4], ob[4];
#pragma unroll
    for (int i = 0; i < 4; ++i) { const f32x4 sc = lv(sl_scale, i, lane) + 1.0f, sh = lv(sl_shift, i, lane); oa[i] = (a[i] - mua) * rsa * sc + sh; ob[i] = (b[i] - mub) * rsb * sc + sh; }
    stvec_bf(ha, oa, lane); stvec_bf(hb_, ob, lane);
}
DI void affine_lds(f32x4 (&v)[4], float mu, float rs, int sl_g, int sl_b, int lane) {
#pragma unroll
    for (int i = 0; i < 4; ++i) v[i] = (v[i] - mu) * rs * lv(sl_g, i, lane) + lv(sl_b, i, lane);
}
constexpr int LNROWS = NWAVE * RPW;

DI void phase_ln0(const Params& p) {
    const int tid_ = otid(), lane = tid_ & 63, wv = tid_ >> 6;
    const float* mod = (const float*)(p.ws + WS_MOD);
    bf16_t* hb = (bf16_t*)(p.ws + WS_HBUF);
    for (int rb = blockIdx.x * LNROWS; rb < NTOK; rb += gridDim.x * LNROWS) {
        const int b = rb / SEQ, r0 = rb + wv * RPW;
        __syncthreads();
        lds_vec_fill(0, mod + (size_t)b * 6144, tid_); lds_vec_fill(1, mod + (size_t)b * 6144 + 1024, tid_);
        __syncthreads();
        RowVec c0, c1;
        ldvec(c0, p.x + (size_t)r0 * D, lane); ldvec(c1, p.x + (size_t)(r0 + 1) * D, lane);
#pragma unroll 1
        for (int k = 0; k < RPW; k += 2) {
            const int row = r0 + k;
            f32x4 va[4], vb[4];
#pragma unroll
            for (int i = 0; i < 4; ++i) { va[i] = c0.v[i]; vb[i] = c1.v[i]; }
            if (k + 2 < RPW) { ldvec(c0, p.x + (size_t)(row + 2) * D, lane); ldvec(c1, p.x + (size_t)(row + 3) * D, lane); }
            modulate_store2(va, vb, 0, 1, hb + (size_t)row * D, hb + (size_t)(row + 1) * D, lane);
        }
    }
}

constexpr int RT_W = 20480, RT_PITCH = 2064, RT_STG = RT_W + 32 * RT_PITCH + 16;
static_assert(RT_STG + NWAVE * 4 * RT_PITCH <= LDS_AUX, "router staging must end below the aux region");
template <bool XBF>
DI void phase_ln1(const Params& p, int l) {
    const int tid_ = otid(), lane = tid_ & 63, wv = tid_ >> 6, fr = lane & 15, fq = lane >> 4;
    const float* mod = (const float*)(p.ws + WS_MOD) + (size_t)l * NB * 6144;
    bf16_t* x1 = (bf16_t*)(p.ws + WS_X1);
    const bf16_t* mix = (const bf16_t*)(p.ws + WS_MIX);
    const bf16_t* xb = (const bf16_t*)(p.ws + WS_XB);
    bf16_t* hb = (bf16_t*)(p.ws + WS_HBUF);
    const bf16_t* btr = (const bf16_t*)(p.ws + WS_BTR);
    const float* rbias = p.router_bias;
    unsigned* cnt = (unsigned*)(p.ws + WS_CTL) + CW_CNT + l * 2048;
    int* tes = (int*)(p.ws + WS_TOKES); float* tg = (float*)(p.ws + WS_TOKG); int* list = (int*)(p.ws + WS_LIST);
    unsigned* hist = (unsigned*)(smem + LDS_AUX + AUX_HIST);
    char* stg = smem + RT_STG + wv * (4 * RT_PITCH);
    struct In { RowVec x; RowRaw xr; RowRaw m; };
    __syncthreads();
    for (int i = tid_; i < 32 * 128; i += NTHR) { const int row = i >> 7, c = i & 127; *(u32x4*)(smem + RT_W + row * RT_PITCH + c * 16) = *(const u32x4*)(btr + (size_t)row * D + c * 8); }
    for (int rb = blockIdx.x * LNROWS; rb < NTOK; rb += gridDim.x * LNROWS) {
        const int b = rb / SEQ, r0 = rb + wv * RPW;
        __syncthreads();
        lds_vec_fill(0, p.ln1_g + l * D, tid_); lds_vec_fill(1, p.ln1_b + l * D, tid_);
        lds_vec_fill(2, mod + (size_t)b * 6144 + 2048, tid_); lds_vec_fill(3, mod + (size_t)b * 6144 + 3072, tid_); lds_vec_fill(4, mod + (size_t)b * 6144 + 4096, tid_);
        if (tid_ < 32) hist[tid_] = 0u;
        __syncthreads();
        auto ldrow = [&](int row, In& q) {
            if (XBF) ldraw(q.xr, xb + (size_t)row * D, lane); else ldvec(q.x, p.x + (size_t)row * D, lane);
            ldraw(q.m, mix + (size_t)row * D, lane);
        };
        auto form = [&](In& q, f32x4 (&v)[4]) {
            RowVec xv, mv; if (XBF) raw2vec(xv, q.xr); else xv = q.x; raw2vec(mv, q.m);
#pragma unroll
            for (int i = 0; i < 4; ++i) v[i] = xv.v[i] * ALPHA + (lv(2, i, lane) + 1.0f) * mv.v[i];
        };
        unsigned pk[RPW / 4]; float ga[RPW / 4];
        In c0, c1;
        ldrow(r0, c0); ldrow(r0 + 1, c1);
#pragma unroll
        for (int k = 0; k < RPW; k += 2) {
            const int row = r0 + k;
            f32x4 va[4], vb[4]; form(c0, va); form(c1, vb);
            if (k + 2 < RPW) { ldrow(row + 2, c0); ldrow(row + 3, c1); }
            float mua, rsa, mub, rsb; row_stats2(va, vb, mua, rsa, mub, rsb);
            affine_lds(va, mua, rsa, 0, 1, lane); affine_lds(vb, mub, rsb, 0, 1, lane);
            stvec_bf(x1 + (size_t)row * D, va, lane); stvec_bf(x1 + (size_t)(row + 1) * D, vb, lane);
            {
                float m2a, r2a, m2b, r2b; row_stats2(va, vb, m2a, r2a, m2b, r2b);
#pragma unroll
                for (int i = 0; i < 2; ++i) {
                    u32x4 wa, wb;
#pragma unroll
                    for (int h = 0; h < 2; ++h) {
                        const f32x4 sc = lv(4, 2 * i + h, lane) + 1.0f, sh = lv(3, 2 * i + h, lane);
                        const f32x4 oa = (va[2 * i + h] - m2a) * r2a * sc + sh, ob = (vb[2 * i + h] - m2b) * r2b * sc + sh;
                        if (h == 0) { wa.x = cvtpk(oa[0], oa[1]); wa.y = cvtpk(oa[2], oa[3]); wb.x = cvtpk(ob[0], ob[1]); wb.y = cvtpk(ob[2], ob[3]); }
                        else { wa.z = cvtpk(oa[0], oa[1]); wa.w = cvtpk(oa[2], oa[3]); wb.z = cvtpk(ob[0], ob[1]); wb.w = cvtpk(ob[2], ob[3]); }
                    }
                    *(u32x4*)(hb + (size_t)row * D + 512 * i + 8 * lane) = wa; *(u32x4*)(hb + (size_t)(row + 1) * D + 512 * i + 8 * lane) = wb;
                    *(u32x4*)(stg + (k & 2) * RT_PITCH + (512 * i + 8 * lane) * 2) = wa; *(u32x4*)(stg + ((k & 2) + 1) * RT_PITCH + (512 * i + 8 * lane) * 2) = wb;
                }
            }
            if ((k & 2) == 0) continue;
            f32x4 acc[2] = {(f32x4){0.f, 0.f, 0.f, 0.f}, (f32x4){0.f, 0.f, 0.f, 0.f}};
            const bool arow_ok = fr < 4;
            const char* ap = stg + (fr & 3) * RT_PITCH + fq * 16;
            const char* bp = smem + RT_W + fr * RT_PITCH + fq * 16;
#pragma unroll 8
            for (int ks = 0; ks < 32; ++ks) {
                u32x4 aw = *(const u32x4*)(ap + ks * 64);
                if (!arow_ok) aw = (u32x4){0u, 0u, 0u, 0u};
                const bf16x8 af = __builtin_bit_cast(bf16x8, aw);
                const bf16x8 b0 = *(const bf16x8*)(bp + ks * 64), b1 = *(const bf16x8*)(bp + 16 * RT_PITCH + ks * 64);
                acc[0] = MFMA16(b0, af, acc[0]); acc[1] = MFMA16(b1, af, acc[1]);
            }
            {
                float sc[8], bs[8];
#pragma unroll
                for (int i = 0; i < 8; ++i) { sc[i] = sigmoidf_(acc[i >> 2][i & 3]); bs[i] = sc[i] + rbias[(i >> 2) * 16 + 4 * fq + (i & 3)]; }
                float gsv[2];
#pragma unroll
                for (int g = 0; g < 2; ++g) {
                    const float a_ = bs[4 * g], b_ = bs[4 * g + 1], c_ = bs[4 * g + 2], d_ = bs[4 * g + 3];
                    const float h1 = fmaxf(a_, b_), l1 = fminf(a_, b_), h2 = fmaxf(c_, d_), l2 = fminf(c_, d_);
                    gsv[g] = fmaxf(h1, h2) + fmaxf(fminf(h1, h2), fmaxf(l1, l2));
                }
                float best = gsv[0]; int bg = fq;
                if (gsv[1] > gsv[0]) { best = gsv[1]; bg = 4 + fq; }
#pragma unroll
                for (int off = 16; off <= 32; off <<= 1) {
                    const float ob = __shfl_xor(best, off); const int og = __shfl_xor(bg, off);
                    if (ob > best || (ob == best && og < bg)) { best = ob; bg = og; }
                }
                pk[k >> 2] = 0u; ga[k >> 2] = 0.f;
                if (arow_ok && (bg & 3) == fq) {
                    const bool up = bg >= 4;
                    float s4[4], b4[4];
#pragma unroll
                    for (int jj = 0; jj < 4; ++jj) { s4[jj] = up ? sc[4 + jj] : sc[jj]; b4[jj] = up ? bs[4 + jj] : bs[jj]; }
                    int i0 = 0; float v0 = b4[0];
#pragma unroll
                    for (int jj = 1; jj < 4; ++jj) if (b4[jj] > v0) { v0 = b4[jj]; i0 = jj; }
                    int i1 = 0; float v1 = -1e30f;
#pragma unroll
                    for (int jj = 0; jj < 4; ++jj) if (jj != i0 && b4[jj] > v1) { v1 = b4[jj]; i1 = jj; }
                    const float sa = i0 == 0 ? s4[0] : i0 == 1 ? s4[1] : i0 == 2 ? s4[2] : s4[3];
                    const float sb = i1 == 0 ? s4[0] : i1 == 1 ? s4[1] : i1 == 2 ? s4[2] : s4[3];
                    ga[k >> 2] = sa / (sa + sb);
                    const unsigned e0 = 4 * bg + i0, e1 = 4 * bg + i1;
                    const unsigned ls0 = atomicAdd(&hist[e0], 1u), ls1 = atomicAdd(&hist[e1], 1u);
                    pk[k >> 2] = e0 | (e1 << 5) | (ls0 << 10) | (ls1 << 19) | (1u << 28);
                }
            }
        }
        __syncthreads();
        if (tid_ < 32) hist[32 + tid_] = atomicAdd(&cnt[64 * tid_], hist[tid_]);
        __syncthreads();
#pragma unroll
        for (int q = 0; q < RPW / 4; ++q) {
            if (pk[q] >> 28) {
                const int tok = r0 + 4 * q + fr;
                const int e0 = pk[q] & 31, e1 = (pk[q] >> 5) & 31;
                const int s0 = (int)hist[32 + e0] + (int)((pk[q] >> 10) & 511), s1 = (int)hist[32 + e1] + (int)((pk[q] >> 19) & 511);
                tes[tok * 2] = (e0 << 24) | s0; tes[tok * 2 + 1] = (e1 << 24) | s1;
                tg[tok * 2] = ga[q]; tg[tok * 2 + 1] = 1.0f - ga[q];
                list[(size_t)e0 * NTOK + s0] = tok; list[(size_t)e1 * NTOK + s1] = tok;
            }
        }
    }
    __syncthreads();
}

DI void phase_ln2(const Params& p, int l, float* xout) {
    const int tid_ = otid(), lane = tid_ & 63, wv = tid_ >> 6;
    const float* mod = (const float*)(p.ws + WS_MOD) + (size_t)l * NB * 6144;
    const bf16_t* x1 = (const bf16_t*)(p.ws + WS_X1);
    bf16_t* xb = (bf16_t*)(p.ws + WS_XB);
    const bf16_t* ys = (const bf16_t*)(p.ws + WS_YS);
    const int* tes = (const int*)(p.ws + WS_TOKES);
    const float* tg = (const float*)(p.ws + WS_TOKG);
    const unsigned* ebase = (const unsigned*)(p.ws + WS_CTL) + CW_BASE + l * 64;
    bf16_t* hb = (bf16_t*)(p.ws + WS_HBUF);
    const float* modn = (const float*)(p.ws + WS_MOD) + (size_t)(l + 1 < DEPTH ? l + 1 : l) * NB * 6144;
    struct In { RowRaw x, y0, y1; };
    for (int rb = blockIdx.x * LNROWS; rb < NTOK; rb += gridDim.x * LNROWS) {
        const int b = rb / SEQ, r0 = rb + wv * RPW;
        __syncthreads();
        lds_vec_fill(0, p.ln2_g + l * D, tid_); lds_vec_fill(1, p.ln2_b + l * D, tid_);
        lds_vec_fill(2, mod + (size_t)b * 6144 + 5120, tid_); lds_vec_fill(3, modn + (size_t)b * 6144, tid_); lds_vec_fill(4, modn + (size_t)b * 6144 + 1024, tid_);
        __syncthreads();
        int es = 0; float gv = 0.f;
        if (lane < 2 * RPW) { es = tes[(size_t)r0 * 2 + lane]; gv = tg[(size_t)r0 * 2 + lane]; es = (int)(ebase[es >> 24] + (unsigned)(es & 0xffffff)); }
        auto ldrow = [&](int k, In& q) {
            const size_t p0 = (size_t)__shfl(es, 2 * k), p1 = (size_t)__shfl(es, 2 * k + 1);
            ldraw(q.x, x1 + (size_t)(r0 + k) * D, lane); ldraw(q.y0, ys + p0 * D, lane); ldraw(q.y1, ys + p1 * D, lane);
        };
        auto form = [&](int k, const In& q, f32x4 (&v)[4]) {
            const float g0 = __shfl(gv, 2 * k), g1 = __shfl(gv, 2 * k + 1);
            RowVec xv, a0, a1; raw2vec(xv, q.x); raw2vec(a0, q.y0); raw2vec(a1, q.y1);
#pragma unroll
            for (int i = 0; i < 4; ++i) v[i] = xv.v[i] * ALPHA + (lv(2, i, lane) + 1.0f) * (a0.v[i] * g0 + a1.v[i] * g1);
        };
        In c0, c1;
        ldrow(0, c0); ldrow(1, c1);
#pragma unroll 1
        for (int k = 0; k < RPW; k += 2) {
            const int row = r0 + k;
            f32x4 va[4], vb[4]; form(k, c0, va); form(k + 1, c1, vb);
            if (k + 2 < RPW) { ldrow(k + 2, c0); ldrow(k + 3, c1); }
            float mua, rsa, mub, rsb; row_stats2(va, vb, mua, rsa, mub, rsb);
            affine_lds(va, mua, rsa, 0, 1, lane); affine_lds(vb, mub, rsb, 0, 1, lane);
            if (l + 1 < DEPTH) {
                stvec_bf(xb + (size_t)row * D, va, lane); stvec_bf(xb + (size_t)(row + 1) * D, vb, lane);
                modulate_store2(va, vb, 3, 4, hb + (size_t)row * D, hb + (size_t)(row + 1) * D, lane);
            } else {
                stvec_f32(xout + (size_t)row * D, va, lane); stvec_f32(xout + (size_t)(row + 1) * D, vb, lane);
            }
        }
    }
}

DI int unit_id(int r) {
    const int g8 = gridDim.x >> 3;
    if ((gridDim.x & 7) != 0) return r * gridDim.x + blockIdx.x;
    return (r * 8 + (blockIdx.x & 7)) * g8 + (blockIdx.x >> 3);
}
DI void st4bf(bf16_t* pz, float a, float b, float c, float d) { u32x2 w; w.x = cvtpk(a, b); w.y = cvtpk(c, d); *(u32x2*)pz = w; }
DI void st4bf(bf16_t* pz, const f32x4& v) { st4bf(pz, v[0], v[1], v[2], v[3]); }
DI int prow(int R) { const int q = R & 31; return (R & ~31) | (8 * ((q & 15) >> 2) + 4 * (q >> 4) + (q & 3)); }
DI int erow(int ai, int wr, int m, int fr) { return ai * 128 + wr * 64 + m * 16 + fr; }
DI int ecol(int bj, int wc, int fq) { return bj * 128 + wc * 32 + 8 * fq; }
DI void st8bf(bf16_t* pz, const f32x4& a, const f32x4& b) { u32x4 w; w.x = cvtpk(a[0], a[1]); w.y = cvtpk(a[2], a[3]); w.z = cvtpk(b[0], b[1]); w.w = cvtpk(b[2], b[3]); *(u32x4*)pz = w; }

constexpr int SL_STAGE = 49152, SL_B = 16384;
template <int MB, int NQ, class ARow, class BRow, class Conv, class Dst>
DI void gemm_slice(const char* abase, const char* bbase, const int KT, const ARow& arow, const BRow& brow, const Conv& conv, const Dst& dst) {
    const int tid = otid(), lane = tid & 63, wid = __builtin_amdgcn_readfirstlane(tid >> 6), wr = wid >> 2, wc = wid & 3, fr = lane & 15, fq = lane >> 4;
    constexpr int NA = MB / 2;
    unsigned ao[NA], bo[4];
#pragma unroll
    for (int i = 0; i < 4; ++i) { int R, C; stage_rc(wid * 1024 + i * 8192 + lane * 16, R, C); bo[i] = brow(R) + 2 * C; if (i < NA) ao[i] = arow(R) + 2 * C; }
#define SL_STAGE_IN(s, kt) do { _Pragma("unroll") for (int i = 0; i < 4; ++i) { \
        if (i < NA) __builtin_amdgcn_global_load_lds((const unsigned*)(abase + ao[i < NA ? i : 0] + (kt) * 128), (unsigned*)(smem + (s) * SL_STAGE + wid * 1024 + i * 8192), 16, 0, 0); \
        __builtin_amdgcn_global_load_lds((const unsigned*)(bbase + bo[i] + (kt) * 128), (unsigned*)(smem + (s) * SL_STAGE + SL_B + wid * 1024 + i * 8192), 16, 0, 0); } } while (0)
    f32x4 acc[MB][4];
#pragma unroll
    for (int m = 0; m < MB; ++m)
#pragma unroll
        for (int n = 0; n < 4; ++n) acc[m][n] = (f32x4){0.f, 0.f, 0.f, 0.f};
    __syncthreads();
    SL_STAGE_IN(0, 0);
    if (KT > 1) SL_STAGE_IN(1, 1);
    int cs = 0;
#pragma unroll 1
    for (int t = 0; t < KT; ++t) {
        if (t + 1 < KT) { if (NA == 1) asm volatile("s_waitcnt vmcnt(5)" ::: "memory"); else asm volatile("s_waitcnt vmcnt(6)" ::: "memory"); }
        else asm volatile("s_waitcnt vmcnt(0)" ::: "memory");
        __syncthreads();
        const int ns = cs == 0 ? 2 : cs - 1;
        if (t + 2 < KT) SL_STAGE_IN(ns, t + 2);
        const char* sa = smem + cs * SL_STAGE; const char* sb = sa + SL_B;
        bf16x8 At[2][MB], Bf[2][4];
#pragma unroll
        for (int ks = 0; ks < 2; ++ks) {
#pragma unroll
            for (int n = 0; n < 4; ++n) Bf[ks][n] = *(const bf16x8*)(sb + lds_byte(wc * 64 + n * 16 + fr, ks * 32 + fq * 8));
#pragma unroll
            for (int m = 0; m < MB; ++m) At[ks][m] = *(const bf16x8*)(sa + lds_byte(wr * (16 * MB) + m * 16 + fr, ks * 32 + fq * 8));
        }
#pragma unroll
        for (int ks = 0; ks < 2; ++ks)
#pragma unroll
            for (int m = 0; m < MB; ++m)
#pragma unroll
                for (int n = 0; n < 4; ++n) acc[m][n] = MFMA16(Bf[ks][n], At[ks][m], acc[m][n]);
        cs = cs == 2 ? 0 : cs + 1;
    }
#undef SL_STAGE_IN
    __syncthreads();
    constexpr int CPRW = 16 * NQ, R = 32 * MB;
    char* F = smem;
#pragma unroll
    for (int m = 0; m < MB; ++m)
#pragma unroll
        for (int q = 0; q < NQ; ++q) {
            f32x4 a, b; conv(acc, m, q, a, b);
            const int row = wr * (16 * MB) + m * 16 + fr, c16 = wc * (4 * NQ) + q * 4 + fq;
            u32x4 w; w.x = cvtpk(a[0], a[1]); w.y = cvtpk(a[2], a[3]); w.z = cvtpk(b[0], b[1]); w.w = cvtpk(b[2], b[3]);
            *(u32x4*)(F + row * (CPRW * 16) + ((c16 ^ (row & (CPRW - 1))) * 16)) = w;
        }
    __syncthreads();
    {
        const int t = otid(), c16 = t & (CPRW - 1), r0 = t / CPRW;
#pragma unroll
        for (int k = 0; k < R * CPRW / NTHR; ++k) {
            const int row = r0 + k * (NTHR / CPRW);
            bf16_t* d = dst(row, c16);
            const u32x4 w = *(const u32x4*)(F + row * (CPRW * 16) + ((c16 ^ (row & (CPRW - 1))) * 16));
            if (d) *(u32x4*)d = w;
        }
    }
    __syncthreads();
}

struct UG1 { int m0, nt; };
DI void phase_gemm1(const Params& p, int l) {
    unsigned char* ws = p.ws;
    const bf16_t* hb = (const bf16_t*)(ws + WS_HBUF);
    const bf16_t* bt = (const bf16_t*)(ws + WS_BTIN) + (size_t)l * INWP * D;
    bf16_t* sbq = (bf16_t*)(ws + WS_SBQ); bf16_t* lat = (bf16_t*)(ws + WS_LAT);
    static_assert(WS_SBK == WS_SBQ + (size_t)NTOK * 1024 && WS_SBV == WS_SBK + (size_t)NTOK * 1024, "sbq|sbk|sbv must be consecutive");
    float* ssl = (float*)(ws + WS_SS) + (size_t)l * 2 * NTOK;
    const float* cs = (const float*)(ws + WS_CS);
    constexpr int NTL = (NTOK / 256) * 8;
    auto get = [=](int r, UG1& u) { const int t = unit_id(r); if (t >= NTL) return false; u.m0 = (t >> 3) * 256; u.nt = (t + r) & 7; return true; };
    auto arow = [=](const UG1& u, int r) { return (unsigned)(u.m0 + r) * (D * 2u); };
    auto brow = [=](const UG1& u, int r) { return (unsigned)(u.nt * 256 + prow(r)) * (D * 2u); };
    auto kf = [=](const UG1&) { return D; };
    auto epi = [=](const UG1& u, const acc_t& acc, int wr, int wc, int fr, int fq) {
        const int m0 = u.m0, nt = u.nt, n0 = nt * 256;
        if (nt < 6) {
            const float sc = nt < 2 ? 0.125f * LOG2E : 1.0f;
            bf16_t* dstb = sbq + (size_t)(nt >> 1) * ((size_t)NTOK * 512) + (n0 & 511);
#pragma unroll
            for (int ai = 0; ai < 2; ++ai)
#pragma unroll
                for (int m = 0; m < 4; ++m) {
                    bf16_t* rp = dstb + (size_t)(m0 + erow(ai, wr, m, fr)) * 512;
#pragma unroll
                    for (int bj = 0; bj < 2; ++bj) st8bf(rp + ecol(bj, wc, fq), acc[ai][bj][m][0] * sc, acc[ai][bj][m][1] * sc);
                }
        } else {
            const bool ropew = nt == 7 && wc == 0;
            const int ci = (8 * fq) & 15;
#pragma unroll
            for (int ai = 0; ai < 2; ++ai)
#pragma unroll
                for (int m = 0; m < 4; ++m) {
                    const int trow = m0 + erow(ai, wr, m, fr);
                    float ssq = 0.f;
#pragma unroll
                    for (int bj = 0; bj < 2; ++bj) {
                        const f32x4 a0 = acc[ai][bj][m][0], a1 = acc[ai][bj][m][1];
                        if (nt == 6 || bj == 0) ssq += ((a0[0] * a0[0] + a0[1] * a0[1]) + (a0[2] * a0[2] + a0[3] * a0[3])) + ((a1[0] * a1[0] + a1[1] * a1[1]) + (a1[2] * a1[2] + a1[3] * a1[3]));
                    }
                    ssq += __shfl_xor(ssq, 16); ssq += __shfl_xor(ssq, 32);
                    if (fq == 0) atomicAdd(&ssl[(size_t)(nt - 6) * NTOK + trow], ssq);
                    bf16_t* rp = lat + (size_t)trow * LATW + (n0 - 1536);
                    st8bf(rp + ecol(0, wc, fq), acc[ai][0][m][0], acc[ai][0][m][1]);
                    if (nt == 6) st8bf(rp + ecol(1, wc, fq), acc[ai][1][m][0], acc[ai][1][m][1]);
                    else if (ropew) {
                        f32x4 a = acc[ai][1][m][0], b = acc[ai][1][m][1];
                        const float* c = cs + (size_t)trow * 32;
                        const f32x4 c0 = *(const f32x4*)(c + ci), c1 = *(const f32x4*)(c + ci + 4), s0 = *(const f32x4*)(c + 16 + ci), s1 = *(const f32x4*)(c + 16 + ci + 4);
                        f32x4 pa, pb;
#pragma unroll
                        for (int i = 0; i < 4; ++i) { pa[i] = xhalf(a[i]); pb[i] = xhalf(b[i]); }
                        if (fq < 2) { a = a * c0 - pa * s0; b = b * c1 - pb * s1; }
                        else        { a = pa * s0 + a * c0; b = pb * s1 + b * c1; }
                        st8bf(rp + ecol(1, wc, fq), a, b);
                    }
                }
        }
    };
    gemm_stream<UG1>((const char*)hb, (const char*)bt, get, arow, brow, kf, epi);
}

struct UG3 { int m0, j; };
DI void phase_mlaprep(const Params& p, int l) {
    unsigned char* ws = p.ws;
    const bf16_t* lat = (const bf16_t*)(ws + WS_LAT);
    const bf16_t* btq = (const bf16_t*)(ws + WS_BTUQ) + (size_t)l * 768 * 256;
    const bf16_t* btkv = (const bf16_t*)(ws + WS_BTUKV) + (size_t)l * 1024 * 128;
    bf16_t* qm = (bf16_t*)(ws + WS_QM); bf16_t* km = (bf16_t*)(ws + WS_KM);
    const float* cs = (const float*)(ws + WS_CS);
    const float* ss_q = (const float*)(ws + WS_SS) + (size_t)l * 2 * NTOK; const float* ss_kv = ss_q + NTOK;
    constexpr int NTL = (NTOK / 256) * 7;
    auto get = [=](int r, UG3& u) { const int t = unit_id(r); if (t >= NTL) return false; u.m0 = (t / 7) * 256; u.j = t % 7; return true; };
    const unsigned kvoff = (unsigned)((const char*)btkv - (const char*)btq);
    auto arow = [=](const UG3& u, int r) { return (unsigned)(u.m0 + r) * (LATW * 2u) + (u.j < 3 ? 0u : 512u); };
    auto brow = [=](const UG3& u, int r) { return u.j < 3 ? (unsigned)(u.j * 256 + prow(r)) * 512u : kvoff + (unsigned)((u.j - 3) * 256 + prow(r)) * 256u; };
    auto kf = [=](const UG3& u) { return u.j < 3 ? 256 : 128; };
    auto epi = [=](const UG3& u, const acc_t& acc, int wr, int wc, int fr, int fq) {
        const int m0 = u.m0, j = u.j;
        const float* ssp = j < 3 ? ss_q : ss_kv;
        const float qs = j < 3 ? 0.10206207261596575f * LOG2E : 1.0f;
        const float inw = j < 3 ? 1.0f / 256.0f : 1.0f / 128.0f;
        bf16_t* dbase = j < 3 ? qm + j * 256 : km + (j - 3) * 256;
        const int dpitch = j < 3 ? 768 : 1024;
#pragma unroll
        for (int ai = 0; ai < 2; ++ai)
#pragma unroll
            for (int m = 0; m < 4; ++m) {
                const int trow = m0 + erow(ai, wr, m, fr);
                const float rs = __builtin_amdgcn_rsqf(ssp[trow] * inw + 1e-6f) * qs;
                bf16_t* rp = dbase + (size_t)trow * dpitch;
#pragma unroll
                for (int bj = 0; bj < 2; ++bj) st8bf(rp + ecol(bj, wc, fq), acc[ai][bj][m][0] * rs, acc[ai][bj][m][1] * rs);
            }
    };
    gemm_stream<UG3>((const char*)lat, (const char*)btq, get, arow, brow, kf, epi);
}

struct UG5 { int m0, n0; };
DI void phase_wo(const Params& p, int l) {
    unsigned char* ws = p.ws;
    const bf16_t* mg = (const bf16_t*)(ws + WS_HBUF);
    const bf16_t* bt = (const bf16_t*)(ws + WS_BTO) + (size_t)l * D * D;
    bf16_t* mix = (bf16_t*)(ws + WS_MIX);
    constexpr int NTL = (NTOK / 256) * 4;
    auto get = [=](int r, UG5& u) { const int t = unit_id(r); if (t >= NTL) return false; u.m0 = (t >> 2) * 256; u.n0 = (t & 3) * 256; return true; };
    auto arow = [=](const UG5& u, int r) { return (unsigned)(u.m0 + r) * (D * 2u); };
    auto brow = [=](const UG5& u, int r) { return (unsigned)(u.n0 + prow(r)) * (D * 2u); };
    auto kf = [=](const UG5&) { return D; };
    auto epi = [=](const UG5& u, const acc_t& acc, int wr, int wc, int fr, int fq) {
#pragma unroll
        for (int ai = 0; ai < 2; ++ai)
#pragma unroll
            for (int m = 0; m < 4; ++m) {
                bf16_t* rp = mix + (size_t)(u.m0 + erow(ai, wr, m, fr)) * D + u.n0;
#pragma unroll
                for (int bj = 0; bj < 2; ++bj) st8bf(rp + ecol(bj, wc, fq), acc[ai][bj][m][0], acc[ai][bj][m][1]);
            }
    };
    gemm_stream<UG5>((const char*)mg, (const char*)bt, get, arow, brow, kf, epi);
}

DI void moe_sched(const Params& p, int l) {
    const unsigned* cnt = (const unsigned*)(p.ws + WS_CTL) + CW_CNT + l * 2048;
    int* cnts = (int*)(smem + LDS_AUX + AUX_CNTS); int* mts = (int*)(smem + LDS_AUX + AUX_MTS); int* rbs = (int*)(smem + LDS_AUX + AUX_RBS);
    __syncthreads();
    if (otid() < 32) cnts[otid()] = (int)cnt[64 * otid()];
    __syncthreads();
    if (otid() == 0) {
        int a = 0, b = 0;
        for (int e = 0; e < 32; ++e) { mts[e] = a; rbs[e] = b; a += (cnts[e] + 255) >> 8; b += cnts[e]; }
        mts[32] = a; rbs[32] = b;
    }
    __syncthreads();
}
struct UGM { int e, mt, nt, ce, rb; };
DI bool moe_unit(int u, int nsh, UGM& o) {
    const int* cnts = (const int*)(smem + LDS_AUX + AUX_CNTS); const int* mts = (const int*)(smem + LDS_AUX + AUX_MTS); const int* rbs = (const int*)(smem + LDS_AUX + AUX_RBS);
    if (u >= (mts[32] << nsh)) return false;
    const int mtg = u >> nsh; int e = 0;
    for (int i = 1; i < 32; ++i) if (mts[i] <= mtg) e = i;
    o.e = e; o.mt = mtg - mts[e]; o.nt = u & ((1 << nsh) - 1); o.ce = cnts[e]; o.rb = rbs[e];
    return true;
}

DI void phase_moe1(const Params& p, int l) {
    unsigned char* ws = p.ws;
    moe_sched(p, l);
    const int* rbs = (const int*)(smem + LDS_AUX + AUX_RBS);
    if (blockIdx.x == 0 && otid() < 32) ((unsigned*)(ws + WS_CTL))[CW_BASE + l * 64 + otid()] = (unsigned)rbs[otid()];
    const bf16_t* hb = (const bf16_t*)(ws + WS_HBUF);
    const int* list = (const int*)(ws + WS_LIST);
    bf16_t* act = (bf16_t*)(ws + WS_ACT);
    const bf16_t* btl = (const bf16_t*)(ws + WS_BTGU) + (size_t)l * NEXP * 512 * D;
    const int G = gridDim.x, total = ((const int*)(smem + LDS_AUX + AUX_MTS))[32] * 2;
    const int full = total / G, n3 = total - full * G;
    const bool split = l + 1 == DEPTH && n3 > 0 && 4 * n3 <= G;
    auto get = [=](int r, UGM& u) { if (split && r >= full) return false; return moe_unit(unit_id(r), 1, u); };
    auto arow = [=](const UGM& u, int r) { int s = u.mt * 256 + r; s = s < u.ce ? s : u.ce - 1; return (unsigned)list[(size_t)u.e * NTOK + s] * (D * 2u); };
    auto brow = [=](const UGM& u, int r) { return (unsigned)(u.e * 512 + u.nt * 256 + prow(r)) * (D * 2u); };
    auto kf = [=](const UGM&) { return D; };
    auto epi = [=](const UGM& u, const acc_t& acc, int wr, int wc, int fr, int fq) {
#pragma unroll
        for (int ai = 0; ai < 2; ++ai)
#pragma unroll
            for (int m = 0; m < 4; ++m) {
                const int s = u.mt * 256 + erow(ai, wr, m, fr);
                f32x4 a, b;
#pragma unroll
                for (int jj = 0; jj < 4; ++jj) { const float g0 = acc[ai][0][m][0][jj], u0 = acc[ai][1][m][0][jj], g1 = acc[ai][0][m][1][jj], u1 = acc[ai][1][m][1][jj]; a[jj] = g0 * sigmoidf_(g0) * u0; b[jj] = g1 * sigmoidf_(g1) * u1; }
                if (s < u.ce) st8bf(act + (size_t)(u.rb + s) * DEXP + u.nt * 128 + wc * 32 + 8 * fq, a, b);
            }
    };
    gemm_stream<UGM>((const char*)hb, (const char*)btl, get, arow, brow, kf, epi);
    if (split) {
        const int v = unit_id(0);
        UGM u;
        if (v < 4 * n3 && moe_unit(full * G + (v >> 2), 1, u)) {
            const int sr = u.mt * 256 + (v & 3) * 64;
            if (sr < u.ce)
                gemm_slice<2, 1>((const char*)hb, (const char*)btl, D / 64,
                    [=](int r) { int s = sr + r; s = s < u.ce ? s : u.ce - 1; return (unsigned)list[(size_t)u.e * NTOK + s] * (D * 2u); },
                    [=](int r) { const int x = prow(r); return (unsigned)(u.e * 512 + u.nt * 256 + ((x >> 5) & 1) * 128 + ((x >> 6) & 3) * 32 + (x & 31)) * (D * 2u); },
                    [=](const f32x4 (&acc)[2][4], int m, int, f32x4& a, f32x4& b) {
#pragma unroll
                        for (int jj = 0; jj < 4; ++jj) { const float g0 = acc[m][0][jj], u0 = acc[m][2][jj], g1 = acc[m][1][jj], u1 = acc[m][3][jj]; a[jj] = g0 * sigmoidf_(g0) * u0; b[jj] = g1 * sigmoidf_(g1) * u1; }
                    },
                    [=](int row, int c16) { const int s = sr + row; return s < u.ce ? act + (size_t)(u.rb + s) * DEXP + u.nt * 128 + c16 * 8 : (bf16_t*)nullptr; });
        }
    }
    if (l + 1 < DEPTH) {
        const int v = unit_id(0);
        int first, stride;
        if (n3 == 0) { first = v; stride = G; } else { first = v - n3; stride = G - n3; }
        if (first >= 0) conv_run(p, l + 1, false, first, stride);
    }
}

DI void phase_moe2(const Params& p, int l) {
    unsigned char* ws = p.ws;
    moe_sched(p, l);
    const bf16_t* act = (const bf16_t*)(ws + WS_ACT);
    bf16_t* ys = (bf16_t*)(ws + WS_YS);
    const bf16_t* btl = (const bf16_t*)(ws + WS_BTD) + (size_t)l * NEXP * D * DEXP;
    const int G = gridDim.x, total = ((const int*)(smem + LDS_AUX + AUX_MTS))[32] * 4;
    const int full = total / G, n3 = total - full * G;
    const int nsl = n3 == 0 ? 1 : 4 * n3 <= G ? 4 : 2 * n3 <= G ? 2 : 1;
    auto get = [=](int r, UGM& u) { if (nsl > 1 && r >= full) return false; return moe_unit(unit_id(r), 2, u); };
    auto arow = [=](const UGM& u, int r) { int s = u.mt * 256 + r; s = s < u.ce ? s : u.ce - 1; return (unsigned)(u.rb + s) * (DEXP * 2u); };
    auto brow = [=](const UGM& u, int r) { return (unsigned)(u.e * D + u.nt * 256 + prow(r)) * (DEXP * 2u); };
    auto kf = [=](const UGM&) { return DEXP; };
    auto epi = [=](const UGM& u, const acc_t& acc, int wr, int wc, int fr, int fq) {
#pragma unroll
        for (int ai = 0; ai < 2; ++ai)
#pragma unroll
            for (int m = 0; m < 4; ++m) {
                const int s = u.mt * 256 + erow(ai, wr, m, fr);
                if (s < u.ce) {
                    bf16_t* rp = ys + (size_t)(u.rb + s) * D + u.nt * 256;
#pragma unroll
                    for (int bj = 0; bj < 2; ++bj) st8bf(rp + ecol(bj, wc, fq), acc[ai][bj][m][0], acc[ai][bj][m][1]);
                }
            }
    };
    gemm_stream<UGM>((const char*)act, (const char*)btl, get, arow, brow, kf, epi);
    if (nsl > 1) {
        const int v = unit_id(0);
        UGM u;
        if (v < nsl * n3 && moe_unit(full * G + v / nsl, 2, u)) {
            const int sr = u.mt * 256 + (v % nsl) * (256 / nsl);
            if (sr < u.ce) {
                auto sarow = [=](int r) { int s = sr + r; s = s < u.ce ? s : u.ce - 1; return (unsigned)(u.rb + s) * (DEXP * 2u); };
                auto sbrow = [=](int r) { return (unsigned)(u.e * D + u.nt * 256 + prow(r)) * (DEXP * 2u); };
                auto sdst = [=](int row, int c16) { const int s = sr + row; return s < u.ce ? ys + (size_t)(u.rb + s) * D + u.nt * 256 + c16 * 8 : (bf16_t*)nullptr; };
                if (nsl == 4) gemm_slice<2, 2>((const char*)act, (const char*)btl, DEXP / 64, sarow, sbrow, [=](const f32x4 (&acc)[2][4], int m, int q, f32x4& a, f32x4& b) { a = acc[m][2 * q]; b = acc[m][2 * q + 1]; }, sdst);
                else gemm_slice<4, 2>((const char*)act, (const char*)btl, DEXP / 64, sarow, sbrow, [=](const f32x4 (&acc)[4][4], int m, int q, f32x4& a, f32x4& b) { a = acc[m][2 * q]; b = acc[m][2 * q + 1]; }, sdst);
            }
        }
    }
}

template <int DQK, bool SBM>
DI void attn_unit(const bf16_t* __restrict__ Qb, const int qstr, const bf16_t* __restrict__ Kb, const int kstr, const bf16_t* __restrict__ Vb, const int vstr, bf16_t* Ob, const int qt,
                  const bf16_t* __restrict__ Rb = nullptr, const float* __restrict__ csb = nullptr) {
    constexpr int KSTR = DQK * 2 + 16, KBUF = 64 * KSTR, VBUF = 8192, OFF_V = 2 * KBUF;
    constexpr int CPR = DQK / 8, NCH = 64 * CPR, NKC = (NCH + NTHR - 1) / NTHR, NKS = DQK / 16;
    const int tid = otid(), lane = tid & 63, w = __builtin_amdgcn_readfirstlane(tid >> 6), r32 = lane & 31, hh = lane >> 5;
    const int q0 = qt * 256, qmin = q0 + 32 * w, myq = qmin + r32;
    const int NTL = 4 * qt + 4;
    bf16x8 qf[NKS];
#pragma unroll
    for (int ks = 0; ks < NKS; ++ks) qf[ks] = *(const bf16x8*)(Qb + (size_t)myq * qstr + ks * 16 + hh * 8);
    if (DQK == 96) {
        const float* c = csb + (size_t)myq * 32 + 8 * hh;
        const f32x4 c0 = *(const f32x4*)c, c1 = *(const f32x4*)(c + 4), s0 = *(const f32x4*)(c + 16), s1 = *(const f32x4*)(c + 20);
        const u32x4 w1 = __builtin_bit_cast(u32x4, qf[NKS - 2]), w2 = __builtin_bit_cast(u32x4, qf[NKS - 1]);
        const f32x4 t1a = bf4(w1.x, w1.y), t1b = bf4(w1.z, w1.w), t2a = bf4(w2.x, w2.y), t2b = bf4(w2.z, w2.w);
        const f32x4 o1a = t1a * c0 - t2a * s0, o1b = t1b * c1 - t2b * s1, o2a = t1a * s0 + t2a * c0, o2b = t1b * s1 + t2b * c1;
        u32x4 r1, r2;
        r1.x = cvtpk(o1a[0], o1a[1]); r1.y = cvtpk(o1a[2], o1a[3]); r1.z = cvtpk(o1b[0], o1b[1]); r1.w = cvtpk(o1b[2], o1b[3]);
        r2.x = cvtpk(o2a[0], o2a[1]); r2.y = cvtpk(o2a[2], o2a[3]); r2.z = cvtpk(o2b[0], o2b[1]); r2.w = cvtpk(o2b[2], o2b[3]);
        qf[NKS - 2] = __builtin_bit_cast(bf16x8, r1); qf[NKS - 1] = __builtin_bit_cast(bf16x8, r2);
    }
    f32x16 o[2];
#pragma unroll
    for (int i = 0; i < 16; ++i) { o[0][i] = 0.f; o[1][i] = 0.f; }
    float mrun = 0.f, lrun = 0.f, Lrun = 1.0f;
    f32x16 negm;
#pragma unroll
    for (int i = 0; i < 16; ++i) negm[i] = 0.f;
    u32x4 rkA[NKC], rvA, rkB[NKC], rvB;
    auto gload = [&](int j, u32x4 (&rk)[NKC], u32x4& rv) {
        if (DQK == 96) {
            rk[0] = *(const u32x4*)(Kb + (size_t)(64 * j + (tid >> 3)) * kstr + (tid & 7) * 8);
            if (tid < 256) rk[NKC - 1] = *(const u32x4*)(Rb + (size_t)(64 * j + (tid >> 2)) * LATW + (tid & 3) * 8);
        } else {
#pragma unroll
            for (int i = 0; i < NKC; ++i) { const int cid = tid + NTHR * i; if (cid < NCH) { const int row = cid / CPR, c = cid % CPR; rk[i] = *(const u32x4*)(Kb + (size_t)(64 * j + row) * kstr + c * 8); } }
        }
        { const int row = tid >> 3, c = tid & 7; rv = *(const u32x4*)(Vb + (size_t)(64 * j + row) * vstr + c * 8); }
    };
    auto lstore = [&](int buf, const u32x4 (&rk)[NKC], const u32x4& rv) {
        if (DQK == 96) {
            *(u32x4*)(smem + buf * KBUF + (tid >> 3) * KSTR + (tid & 7) * 16) = rk[0];
            if (tid < 256) *(u32x4*)(smem + buf * KBUF + (tid >> 2) * KSTR + (8 + (tid & 3)) * 16) = rk[NKC - 1];
        } else {
#pragma unroll
            for (int i = 0; i < NKC; ++i) { const int cid = tid + NTHR * i; if (cid < NCH) { const int row = cid / CPR, c = cid % CPR; *(u32x4*)(smem + buf * KBUF + row * KSTR + c * 16) = rk[i]; } }
        }
        { const int row = tid >> 3, c = tid & 7; *(u32x4*)(smem + OFF_V + buf * VBUF + (c >> 2) * 4096 + row * 64 + (c & 3) * 16) = rv; }
    };
    unsigned* flags = (unsigned*)(smem + LDS_AUX + AUX_FLAGS);
#define RAW_BARRIER() asm volatile("s_waitcnt lgkmcnt(0)\n\ts_barrier" ::: "memory")
    gload(SBM ? NTL - 1 : 0, rkA, rvA); lstore(0, rkA, rvA);
    gload(SBM ? NTL - 2 : 1, rkA, rvA);
    RAW_BARRIER();
    bool done = false;
    auto step = [&](const int it, u32x4 (&rkH)[NKC], u32x4& rvH, u32x4 (&rkL)[NKC], u32x4& rvL) {
        const int j = SBM ? NTL - 1 - it : it, buf = it & 1;
        if (it + 2 < NTL) gload(SBM ? j - 2 : j + 2, rkL, rvL);
        const int kmin = 64 * j;
        const bool none = SBM ? (kmin >= qmin + 31 || !__any(Lrun > 0.f)) : (kmin > qmin + 31);
        if (!none) {
            const bool full = SBM ? (kmin + 63 < qmin) : (kmin + 63 <= qmin);
            f32x16 s[2];
            bf16x8 kf[2][NKS], vf[2][4];
#pragma unroll
            for (int ks = 0; ks < NKS; ++ks)
#pragma unroll
                for (int kb = 0; kb < 2; ++kb) kf[kb][ks] = *(const bf16x8*)(smem + buf * KBUF + (32 * kb + r32) * KSTR + ks * 32 + hh * 16);
#pragma unroll
            for (int ks = 0; ks < NKS; ++ks)
#pragma unroll
                for (int kb = 0; kb < 2; ++kb) s[kb] = MFMA(kf[kb][ks], qf[ks], ks == 0 ? negm : s[kb]);
            {
                typedef short v4i16_t __attribute__((ext_vector_type(4)));
                typedef __attribute__((address_space(3))) v4i16_t* lds_v4p;
                const int vbase = OFF_V + buf * VBUF + ((lane >> 4) & 1) * 32 + (lane & 3) * 8 + (4 * hh + ((lane & 15) >> 2)) * 64;
#pragma unroll
                for (int kx = 0; kx < 4; ++kx)
#pragma unroll
                    for (int db = 0; db < 2; ++db) {
                        const v4i16_t lo = __builtin_amdgcn_ds_read_tr16_b64_v4i16((lds_v4p)(smem + vbase + db * 4096 + kx * 1024));
                        const v4i16_t hi = __builtin_amdgcn_ds_read_tr16_b64_v4i16((lds_v4p)(smem + vbase + db * 4096 + kx * 1024 + 512));
                        vf[db][kx] = (bf16x8){lo[0], lo[1], lo[2], lo[3], hi[0], hi[1], hi[2], hi[3]};
                    }
            }
            if (!SBM) {
                if (!full) {
#pragma unroll
                    for (int kb = 0; kb < 2; ++kb)
#pragma unroll
                        for (int i = 0; i < 16; ++i) if (kmin + 32 * kb + crow(i, hh) > myq) s[kb][i] = -INFINITY;
                }
                float mx = s[0][0];
#pragma unroll
                for (int kb = 0; kb < 2; ++kb)
#pragma unroll
                    for (int i = 0; i < 16; ++i) mx = fmaxf(mx, s[kb][i]);
                mx = fmaxf(mx, xhalf(mx));
                if (it == 0 || __any(mx > 8.0f)) {
                    const float d = it == 0 ? mx : fmaxf(mx, 0.f);
                    mrun += d;
                    const float al = it == 0 ? 1.0f : fexp2(-d);
                    lrun *= al;
#pragma unroll
                    for (int kb = 0; kb < 2; ++kb)
#pragma unroll
                        for (int i = 0; i < 16; ++i) s[kb][i] -= d;
#pragma unroll
                    for (int i = 0; i < 16; ++i) { o[0][i] *= al; o[1][i] *= al; negm[i] = -mrun; }
                }
                float rs = 0.f;
#pragma unroll
                for (int kb = 0; kb < 2; ++kb)
#pragma unroll
                    for (int i = 0; i < 16; ++i) { const float pz = fexp2(s[kb][i]); s[kb][i] = pz; rs += pz; }
                lrun += rs;
            } else {
                f32x16 kp[2];
#pragma unroll
                for (int kb = 0; kb < 2; ++kb)
#pragma unroll
                    for (int i = 0; i < 16; ++i) {
                        const float u = fexp2(fminf(s[kb][i], 100.0f));
                        float k_ = frcp(1.0f + u), b_ = u * k_;
                        if (!full && !(kmin + 32 * kb + crow(i, hh) < myq)) { k_ = 1.0f; b_ = 0.f; }
                        kp[kb][i] = k_; s[kb][i] = b_;
                    }
                float run = Lrun;
#pragma unroll
                for (int kb = 1; kb >= 0; --kb)
#pragma unroll
                    for (int g = 3; g >= 0; --g) {
                        const float G = (kp[kb][4 * g] * kp[kb][4 * g + 1]) * (kp[kb][4 * g + 2] * kp[kb][4 * g + 3]);
                        const float Gp = xhalf(G);
                        float a_ = hh ? run : run * Gp;
#pragma unroll
                        for (int jl = 3; jl >= 0; --jl) {
                            const int i = 4 * g + jl;
                            s[kb][i] *= a_;
                            a_ *= kp[kb][i];
                        }
                        run *= G * Gp;
                    }
                Lrun = run;
            }
#pragma unroll
            for (int kb = 0; kb < 2; ++kb)
#pragma unroll
                for (int sx = 0; sx < 2; ++sx) {
                    u32x4 pw;
                    pw.x = cvtpk(s[kb][8 * sx], s[kb][8 * sx + 1]); pw.y = cvtpk(s[kb][8 * sx + 2], s[kb][8 * sx + 3]);
                    pw.z = cvtpk(s[kb][8 * sx + 4], s[kb][8 * sx + 5]); pw.w = cvtpk(s[kb][8 * sx + 6], s[kb][8 * sx + 7]);
                    const bf16x8 pk = __builtin_bit_cast(bf16x8, pw);
#pragma unroll
                    for (int db = 0; db < 2; ++db) o[db] = MFMA(vf[db][2 * kb + sx], pk, o[db]);
                }
        }
        if (it + 1 < NTL) lstore(buf ^ 1, rkH, rvH);
        if (SBM) { const bool alive = __any(Lrun > 0.f); if (lane == 0) flags[(it & 1) * 8 + w] = alive ? 1u : 0u; }
        RAW_BARRIER();
        if (SBM) {
            unsigned f = 0u;
#pragma unroll
            for (int q = 0; q < 8; ++q) f |= flags[(it & 1) * 8 + q];
            if (f == 0u) done = true;
        }
    };
    for (int it = 0; it < NTL && !done; it += 2) {
        step(it, rkA, rvA, rkB, rvB);
        if (done) break;
        step(it + 1, rkB, rvB, rkA, rvA);
    }
    float inv = 1.0f;
    if (!SBM) { const float lt = lrun + xhalf(lrun); inv = 1.0f / lt; }
#pragma unroll
    for (int db = 0; db < 2; ++db)
#pragma unroll
        for (int g = 0; g < 4; ++g)
            st4bf(Ob + (size_t)myq * D + 32 * db + 8 * g + 4 * hh, o[db][4 * g] * inv, o[db][4 * g + 1] * inv, o[db][4 * g + 2] * inv, o[db][4 * g + 3] * inv);
    RAW_BARRIER();
#undef RAW_BARRIER
}

DI void sb_wave(const bf16_t* __restrict__ Qb, const bf16_t* __restrict__ Kb, const bf16_t* __restrict__ Vb, bf16_t* Ob, const int Q0_) {
    const int Q0 = __builtin_amdgcn_readfirstlane(Q0_);
    const int tid = otid(), lane = tid & 63, w = __builtin_amdgcn_readfirstlane(tid >> 6), r32 = lane & 31, hh = lane >> 5;
    char* kl = smem + w * 16384; char* vl = kl + 8192;
    const int myq = Q0 + r32, jt = Q0 >> 6;
    bf16x8 qf[4];
#pragma unroll
    for (int ks = 0; ks < 4; ++ks) qf[ks] = *(const bf16x8*)(Qb + (size_t)myq * 512 + ks * 16 + hh * 8);
    f32x16 o[2];
#pragma unroll
    for (int i = 0; i < 16; ++i) { o[0][i] = 0.f; o[1][i] = 0.f; }
    float Prun = 1.0f;
    u32x4 rk[8], rv[8];
    const int lrow = lane >> 3, lc = lane & 7;
    auto gloadK = [&](int j) {
#pragma unroll
        for (int i = 0; i < 8; ++i) rk[i] = *(const u32x4*)(Kb + (size_t)(64 * j + lrow + 8 * i) * 512 + lc * 8);
    };
    auto gloadV = [&](int j, int half) {
#pragma unroll
        for (int i = 0; i < 4; ++i) rv[4 * half + i] = *(const u32x4*)(Vb + (size_t)(64 * j + lrow + 8 * (4 * half + i)) * 512 + lc * 8);
    };
    auto lstoreK = [&]() {
#pragma unroll
        for (int i = 0; i < 8; ++i) { const int row = lrow + 8 * i; *(u32x4*)(kl + row * 128 + ((lc ^ (row & 7)) * 16)) = rk[i]; }
    };
    auto lstoreV = [&]() {
#pragma unroll
        for (int i = 0; i < 8; ++i) { const int row = lrow + 8 * i; *(u32x4*)(vl + (lc >> 2) * 4096 + row * 64 + (lc & 3) * 16) = rv[i]; }
    };
    gloadK(jt); lstoreK();
    for (int j = jt; j >= 0; --j) {
        if (j > 0) gloadK(j - 1);
        gloadV(j, 0);
        const int kmin = 64 * j;
        const bool full = j != jt;
        f32x16 s[2];
        {
            bf16x8 kf[2][4];
#pragma unroll
            for (int ks = 0; ks < 4; ++ks)
#pragma unroll
                for (int kb = 0; kb < 2; ++kb) { const int row = 32 * kb + r32; kf[kb][ks] = *(const bf16x8*)(kl + row * 128 + (((2 * ks + hh) ^ (row & 7)) * 16)); }
#pragma unroll
            for (int kb = 0; kb < 2; ++kb)
#pragma unroll
                for (int i = 0; i < 16; ++i) s[kb][i] = 0.f;
#pragma unroll
            for (int ks = 0; ks < 4; ++ks)
#pragma unroll
                for (int kb = 0; kb < 2; ++kb) s[kb] = MFMA(kf[kb][ks], qf[ks], s[kb]);
        }
        gloadV(j, 1);
        f32x16 kp[2];
#pragma unroll
        for (int kb = 0; kb < 2; ++kb)
#pragma unroll
            for (int i = 0; i < 16; ++i) {
                const float u = fexp2(s[kb][i]);
                float k_ = frcp(1.0f + u), b_ = 1.0f - k_;
                if (!full && !(kmin + 32 * kb + crow(i, hh) < myq)) { k_ = 1.0f; b_ = 0.f; }
                kp[kb][i] = k_; s[kb][i] = b_;
            }
        float run = Prun;
#pragma unroll
        for (int kb = 1; kb >= 0; --kb)
#pragma unroll
            for (int g = 3; g >= 0; --g) {
                const float G = (kp[kb][4 * g] * kp[kb][4 * g + 1]) * (kp[kb][4 * g + 2] * kp[kb][4 * g + 3]);
                const float Gp = xhalf(G);
                float a_ = hh ? run : run * Gp;
#pragma unroll
                for (int jl = 3; jl >= 0; --jl) { const int i = 4 * g + jl; s[kb][i] *= a_; a_ *= kp[kb][i]; }
                run *= G * Gp;
            }
        Prun = run;
        lstoreV();
        bf16x8 vf[2][4];
        {
            typedef short v4i16_t __attribute__((ext_vector_type(4)));
            typedef __attribute__((address_space(3))) v4i16_t* lds_v4p;
            const char* vbase = vl + ((lane >> 4) & 1) * 32 + (lane & 3) * 8 + (4 * hh + ((lane & 15) >> 2)) * 64;
#pragma unroll
            for (int kx = 0; kx < 4; ++kx)
#pragma unroll
                for (int db = 0; db < 2; ++db) {
                    const v4i16_t lo = __builtin_amdgcn_ds_read_tr16_b64_v4i16((lds_v4p)(vbase + db * 4096 + kx * 1024));
                    const v4i16_t hi = __builtin_amdgcn_ds_read_tr16_b64_v4i16((lds_v4p)(vbase + db * 4096 + kx * 1024 + 512));
                    vf[db][kx] = (bf16x8){lo[0], lo[1], lo[2], lo[3], hi[0], hi[1], hi[2], hi[3]};
                }
        }
#pragma unroll
        for (int kb = 0; kb < 2; ++kb)
#pragma unroll
            for (int sx = 0; sx < 2; ++sx) {
                u32x4 pw;
                pw.x = cvtpk(s[kb][8 * sx], s[kb][8 * sx + 1]); pw.y = cvtpk(s[kb][8 * sx + 2], s[kb][8 * sx + 3]);
                pw.z = cvtpk(s[kb][8 * sx + 4], s[kb][8 * sx + 5]); pw.w = cvtpk(s[kb][8 * sx + 6], s[kb][8 * sx + 7]);
                const bf16x8 pk = __builtin_bit_cast(bf16x8, pw);
#pragma unroll
                for (int db = 0; db < 2; ++db) o[db] = MFMA(vf[db][2 * kb + sx], pk, o[db]);
            }
        if (!__any(Prun > 0.f)) break;
        if (j > 0) lstoreK();
    }
#pragma unroll
    for (int db = 0; db < 2; ++db)
#pragma unroll
        for (int g = 0; g < 4; ++g)
            st4bf(Ob + (size_t)myq * D + 32 * db + 8 * g + 4 * hh, o[db][4 * g], o[db][4 * g + 1], o[db][4 * g + 2], o[db][4 * g + 3]);
}

DI void phase_attn(const Params& p, int l) {
    unsigned char* ws = p.ws;
    int* slot = (int*)(smem + LDS_AUX + AUX_SLOT);
    bf16_t* mg = (bf16_t*)(ws + WS_HBUF);
    auto fetch = [&](unsigned* head) { int v = 0; if (otid() == 0) v = (int)__hip_atomic_fetch_add(head, 1u, __ATOMIC_RELAXED, __HIP_MEMORY_SCOPE_AGENT); return v; };
    auto share = [&](int v) { __syncthreads(); if (otid() == 0) *slot = v; __syncthreads(); return *slot; };
    {
        unsigned* head = (unsigned*)(ws + WS_CTL) + CW_ATTQ + 64 * l;
        const bf16_t* qm = (const bf16_t*)(ws + WS_QM); const bf16_t* km = (const bf16_t*)(ws + WS_KM); const bf16_t* lat = (const bf16_t*)(ws + WS_LAT); const float* cs = (const float*)(ws + WS_CS);
        int u = share(fetch(head));
        while (u < 1024) {
            const int nx = fetch(head);
            const int qt = 7 - (u >> 7), bh = u & 127, b = bh >> 3, h = bh & 7;
            const size_t t0 = (size_t)b * SEQ;
            attn_unit<96, false>(qm + t0 * 768 + h * 96, 768, km + (t0 * 8 + h) * KVREC, 8 * KVREC, km + (t0 * 8 + h) * KVREC + 64, 8 * KVREC, mg + t0 * D + 512 + h * 64, qt, lat + t0 * LATW + 384, cs + t0 * 32);
            u = share(nx);
        }
    }
    {
        unsigned* head = (unsigned*)(ws + WS_CTL) + CW_ATTQ + 64 * (l + DEPTH);
        const bf16_t* sbq = (const bf16_t*)(ws + WS_SBQ); const bf16_t* sbk = (const bf16_t*)(ws + WS_SBK); const bf16_t* sbv = (const bf16_t*)(ws + WS_SBV);
        int u = share(fetch(head));
        while (u < 1024) {
            const int nx = fetch(head);
            const int qt = 7 - (u >> 7), bh = u & 127, b = bh >> 3, h = bh & 7;
            const size_t t0 = (size_t)b * SEQ;
            sb_wave(sbq + t0 * 512 + h * 64, sbk + t0 * 512 + h * 64, sbv + t0 * 512 + h * 64, mg + t0 * D + h * 64, qt * 256 + 32 * (int)(otid() >> 6));
            u = share(nx);
        }
    }
}

#ifndef TIMEPH
#define TIMEPH -1
#endif
#define PHASE(id, call, sync) do { if (TIMEPH == (id)) ts_ = __builtin_amdgcn_s_memrealtime(); call; if ((sync) || TIMEPH == (id)) xcd_barrier(bar); \
                                   if (TIMEPH == (id)) tacc_ += __builtin_amdgcn_s_memrealtime() - ts_; } while (0)
__global__ void __launch_bounds__(NTHR, 2) fwd_kernel(Params p) {
    if (threadIdx.x == 0) *(uint4*)(smem + LDS_BAR) = make_uint4(0u, 0u, 0u, 0u);
    __syncthreads();
    XcdBarrier bar = xcd_barrier_post((unsigned*)(p.ws + WS_CTL), (volatile LAS unsigned*)(smem + LDS_BAR));
    unsigned long long ts_ = 0, tacc_ = 0;
    PHASE(0, phase0(p), true);
    PHASE(1, phase_ln0(p), true);
    for (int l = 0; l < DEPTH; ++l) {
        PHASE(2, phase_gemm1(p, l), true);
        PHASE(3, phase_mlaprep(p, l), true);
        PHASE(4, phase_attn(p, l), true);
        PHASE(5, phase_wo(p, l), true);
        PHASE(6, if (l == 0) phase_ln1<false>(p, l); else phase_ln1<true>(p, l), true);
        PHASE(8, phase_moe1(p, l), true);
        PHASE(9, phase_moe2(p, l), true);
        PHASE(10, phase_ln2(p, l, p.out), l + 1 < DEPTH);
    }
    if (TIMEPH >= 0) { const unsigned long long te = __builtin_amdgcn_s_memrealtime(); while (__builtin_amdgcn_s_memrealtime() - te < tacc_) __builtin_amdgcn_s_sleep(8); }
}

extern "C" void kernel_launch(void* const* d_in, const int* in_sizes, int n_in, void* d_out, int out_size, void* d_ws, size_t ws_size, hipStream_t stream) {
    static int grid = 0;
    if (grid == 0) {
        if (n_in != 20 || out_size != NTOK * D || ws_size < WS_END) { fprintf(stderr, "kernel_launch: unexpected shapes (n_in %d, out %d, ws %zu, need %zu)\n", n_in, out_size, ws_size, (size_t)WS_END); grid = -1; return; }
        int dev = 0, cus = 0, per_cu = 0;
        if (hipGetDevice(&dev) != hipSuccess || hipDeviceGetAttribute(&cus, hipDeviceAttributeMultiprocessorCount, dev) != hipSuccess) { grid = -1; return; }
        if (hipFuncSetAttribute((const void*)fwd_kernel, hipFuncAttributeMaxDynamicSharedMemorySize, LDS_BYTES) != hipSuccess) { fprintf(stderr, "kernel_launch: hipFuncSetAttribute failed\n"); grid = -1; return; }
        if (hipOccupancyMaxActiveBlocksPerMultiprocessor(&per_cu, (const void*)fwd_kernel, NTHR, LDS_BYTES) != hipSuccess || per_cu < 1) { fprintf(stderr, "kernel_launch: occupancy query failed (%d)\n", per_cu); per_cu = 1; }
        (void)hipGetLastError();
        grid = cus;
    }
    if (grid < 0) return;
    (void)hipMemsetAsync((char*)d_ws + WS_CTL, 0, CTL_BYTES + SS_BYTES, stream);
    Params p{};
    p.x = (const float*)d_in[0]; p.c = (const float*)d_in[1]; p.pos = (const int*)d_in[2];
    p.ada_w = (const float*)d_in[3]; p.ada_b = (const float*)d_in[4]; p.w_in = (const float*)d_in[5]; p.q_norm = (const float*)d_in[6]; p.kv_norm = (const float*)d_in[7];
    p.w_uq = (const float*)d_in[8]; p.w_ukv = (const float*)d_in[9]; p.w_o = (const float*)d_in[10]; p.ln1_g = (const float*)d_in[11]; p.ln1_b = (const float*)d_in[12];
    p.router_w = (const float*)d_in[13]; p.router_bias = (const float*)d_in[14]; p.w_gate = (const float*)d_in[15]; p.w_up = (const float*)d_in[16]; p.w_down = (const float*)d_in[17];
    p.ln2_g = (const float*)d_in[18]; p.ln2_b = (const float*)d_in[19];
    p.out = (float*)d_out; p.ws = (unsigned char*)d_ws;
    hipLaunchKernelGGL(fwd_kernel, dim3(grid), dim3(NTHR), LDS_BYTES, stream, p);
}
```
